# Optimizing an MI355X kernel written in HIP

```python
import jax, jax.numpy as jnp
from jax import lax
import numpy as np

D_MODEL = 2048
BATCH = 4
SEQ = 2048
DEPTH = 4
DEC_BATCH = 128
DEC_SEQ = 1
PAST_LEN = 16384
PAGE_SIZE = 128

N_MIXERS = 3
N_LAYERS_A = (DEPTH + 2) // 3
N_LAYERS_B = (DEPTH + 1) // 3
N_LAYERS_C = DEPTH // 3
D_FF = 5632
FFN_HALF = 0.5
D_A = D_MODEL
CONV_A_WIDTH = 31
D_SGU = 2 * D_MODEL
CHUNK = 128
N_SGU_GROUPS = 8
D_SGU_GROUP = D_SGU // N_SGU_GROUPS
D_C = D_MODEL
CONV_C_WIDTH = 3
EPS = 1e-6

kernel_name = "hybrid_conformerconv_chunkgmlp_shortconv_step"


def rmsnorm(x, g):
    xf = x.astype(jnp.float32)
    ms = jnp.mean(xf * xf, axis=-1, keepdims=True)
    return (xf * lax.rsqrt(ms + EPS)).astype(x.dtype) * g


def layernorm(x, g, b):
    xf = x.astype(jnp.float32)
    mu = jnp.mean(xf, axis=-1, keepdims=True)
    var = jnp.mean(jnp.square(xf - mu), axis=-1, keepdims=True)
    return ((xf - mu) * lax.rsqrt(var + EPS)).astype(x.dtype) * g + b


def swiglu(h, w_gate, w_up, w_down):
    return (jax.nn.silu(h @ w_gate) * (h @ w_up)) @ w_down


def causal_dwconv(xp, w, t):
    k_w = w.shape[0]
    y = xp[:, 0:t] * w[0]
    for k in range(1, k_w):
        y = y + xp[:, k:k + t] * w[k]
    return y


def conformer_conv(h, buf, w_pw1, b_pw1, w_dw, b_dw, ln_g, ln_b, w_pw2):
    t = h.shape[1]
    a, gate = jnp.split(h @ w_pw1 + b_pw1, 2, axis=-1)
    glu = a * jax.nn.sigmoid(gate)
    xp = jnp.concatenate([buf.astype(glu.dtype), glu], axis=1)
    y = causal_dwconv(xp, w_dw, t) + b_dw
    y = jax.nn.silu(layernorm(y, ln_g, ln_b))
    return y @ w_pw2, xp[:, -(CONV_A_WIDTH - 1):]


def chunked_sgu(h, w_in, b_in, ln_g, ln_b, w_s, b_s, w_out):
    bsz, t, _ = h.shape
    z = jax.nn.gelu(h @ w_in + b_in, approximate=False)
    u, v = jnp.split(z, 2, axis=-1)
    v = layernorm(v, ln_g, ln_b)
    rows = min(t, CHUNK)
    n_chunks = t // rows
    mask = jnp.tril(jnp.ones((rows, rows), dtype=bool))
    ws = jnp.where(mask[None], w_s[:, :rows, :rows], jnp.zeros((), w_s.dtype))
    vg = v.reshape(bsz, n_chunks, rows, N_SGU_GROUPS, D_SGU_GROUP)
    s = jnp.einsum('gts,bnsgd->bntgd', ws, vg) + jnp.transpose(b_s[:, :rows])[None, None, :, :, None]
    y = u * s.reshape(bsz, t, D_SGU)
    return y @ w_out, v[:, t - rows:]


def short_gated_conv(h, buf, w_in, w_conv, w_out):
    t = h.shape[1]
    b_gate, c_gate, xin = jnp.split(h @ w_in, 3, axis=-1)
    cx = c_gate * xin
    xp = jnp.concatenate([buf.astype(cx.dtype), cx], axis=1)
    y = b_gate * causal_dwconv(xp, w_conv, t)
    return y @ w_out, xp[:, -(CONV_C_WIDTH - 1):]


def setup_inputs(seed: int = 0) -> dict:
    key = jax.random.key(seed)
    ks = jax.random.split(key, 32)
    nrm = lambda k, shape, scale: jax.random.normal(k, shape, jnp.float32) * scale
    gain = lambda k, shape: 1.0 + nrm(k, shape, 0.01)
    return {
        "x_prompt": nrm(ks[0], (BATCH, SEQ, D_MODEL), 1.0),
        "x_sample": nrm(ks[1], (DEC_BATCH, DEC_SEQ, D_MODEL), 1.0),
        "state_conv_a": nrm(ks[2], (N_LAYERS_A, DEC_BATCH, CONV_A_WIDTH - 1, D_A), 0.5),
        "state_conv_c": nrm(ks[3], (N_LAYERS_C, DEC_BATCH, CONV_C_WIDTH - 1, D_C), 0.5),
        "g_ffn1": gain(ks[4], (DEPTH, D_MODEL)),
        "g_mix": gain(ks[5], (DEPTH, D_MODEL)),
        "g_ffn2": gain(ks[6], (DEPTH, D_MODEL)),
        "g_final": gain(ks[7], (D_MODEL,)),
        "w_ffn_gate": nrm(ks[8], (DEPTH, 2, D_MODEL, D_FF), D_MODEL ** -0.5),
        "w_ffn_up": nrm(ks[9], (DEPTH, 2, D_MODEL, D_FF), D_MODEL ** -0.5),
        "w_ffn_down": nrm(ks[10], (DEPTH, 2, D_FF, D_MODEL), D_FF ** -0.5),
        "a_w_pw1": nrm(ks[11], (N_LAYERS_A, D_MODEL, 2 * D_A), D_MODEL ** -0.5),
        "a_b_pw1": nrm(ks[12], (N_LAYERS_A, 2 * D_A), 0.02),
        "a_w_dw": nrm(ks[13], (N_LAYERS_A, CONV_A_WIDTH, D_A), CONV_A_WIDTH ** -0.5),
        "a_b_dw": nrm(ks[14], (N_LAYERS_A, D_A), 0.02),
        "a_ln_g": gain(ks[15], (N_LAYERS_A, D_A)),
        "a_ln_b": nrm(ks[16], (N_LAYERS_A, D_A), 0.02),
        "a_w_pw2": nrm(ks[17], (N_LAYERS_A, D_A, D_MODEL), D_A ** -0.5),
        "b_w_in": nrm(ks[18], (N_LAYERS_B, D_MODEL, 2 * D_SGU), D_MODEL ** -0.5),
        "b_b_in": nrm(ks[19], (N_LAYERS_B, 2 * D_SGU), 0.02),
        "b_ln_g": gain(ks[20], (N_LAYERS_B, D_SGU)),
        "b_ln_b": nrm(ks[21], (N_LAYERS_B, D_SGU), 0.02),
        "b_w_s": nrm(ks[22], (N_LAYERS_B, N_SGU_GROUPS, CHUNK, CHUNK), CHUNK ** -0.5),
        "b_b_s": 1.0 + nrm(ks[23], (N_LAYERS_B, N_SGU_GROUPS, CHUNK), 0.02),
        "b_w_out": nrm(ks[24], (N_LAYERS_B, D_SGU, D_MODEL), D_SGU ** -0.5),
        "c_w_in": nrm(ks[25], (N_LAYERS_C, D_MODEL, 3 * D_C), D_MODEL ** -0.5),
        "c_w_conv": nrm(ks[26], (N_LAYERS_C, CONV_C_WIDTH, D_C), CONV_C_WIDTH ** -0.5),
        "c_w_out": nrm(ks[27], (N_LAYERS_C, D_C, D_MODEL), D_C ** -0.5),
    }


def reference(x_prompt, x_sample, state_conv_a, state_conv_c,
              g_ffn1, g_mix, g_ffn2, g_final,
              w_ffn_gate, w_ffn_up, w_ffn_down,
              a_w_pw1, a_b_pw1, a_w_dw, a_b_dw, a_ln_g, a_ln_b, a_w_pw2,
              b_w_in, b_b_in, b_ln_g, b_ln_b, b_w_s, b_b_s, b_w_out,
              c_w_in, c_w_conv, c_w_out):

    def run(x, buf_a, buf_c):
        new_a, new_b, new_c = [], [], []
        for i in range(DEPTH):
            x = x + FFN_HALF * swiglu(rmsnorm(x, g_ffn1[i]), w_ffn_gate[i, 0], w_ffn_up[i, 0], w_ffn_down[i, 0])
            h = rmsnorm(x, g_mix[i])
            kind, j = i % N_MIXERS, i // N_MIXERS
            if kind == 0:
                m, s = conformer_conv(h, buf_a[j], a_w_pw1[j], a_b_pw1[j], a_w_dw[j], a_b_dw[j],
                                      a_ln_g[j], a_ln_b[j], a_w_pw2[j])
                new_a.append(s)
            elif kind == 1:
                m, s = chunked_sgu(h, b_w_in[j], b_b_in[j], b_ln_g[j], b_ln_b[j], b_w_s[j], b_b_s[j], b_w_out[j])
                new_b.append(s)
            else:
                m, s = short_gated_conv(h, buf_c[j], c_w_in[j], c_w_conv[j], c_w_out[j])
                new_c.append(s)
            x = x + m
            x = x + FFN_HALF * swiglu(rmsnorm(x, g_ffn2[i]), w_ffn_gate[i, 1], w_ffn_up[i, 1], w_ffn_down[i, 1])
        return rmsnorm(x, g_final), jnp.stack(new_a), jnp.stack(new_b), jnp.stack(new_c)

    zeros_a = jnp.zeros((N_LAYERS_A, BATCH, CONV_A_WIDTH - 1, D_A), x_prompt.dtype)
    zeros_c = jnp.zeros((N_LAYERS_C, BATCH, CONV_C_WIDTH - 1, D_C), x_prompt.dtype)
    y_prompt, conv_a_p, sgu_v_p, conv_c_p = run(x_prompt, zeros_a, zeros_c)
    y_sample, conv_a_s, sgu_v_s, conv_c_s = run(x_sample, state_conv_a, state_conv_c)
    return (y_prompt, y_sample, conv_a_p, conv_a_s, sgu_v_p, sgu_v_s, conv_c_p, conv_c_s)
```

```cpp
#include <hip/hip_runtime.h>
#include <cstdio>
#include <cstdint>
#define GAS __attribute__((address_space(1)))
#define LAS __attribute__((address_space(3)))
namespace pg8 {
#define PG8_LAS __attribute__((address_space(3)))
typedef unsigned short bf16_t;
typedef short bf16x8 __attribute__((ext_vector_type(8)));
typedef float f32x4 __attribute__((ext_vector_type(4)));
typedef unsigned u32x4 __attribute__((ext_vector_type(4)));
constexpr int BM = 256, BK = 64, HALF = 128, HTB = HALF * BK * 2  , STAGE_BYTES = 8 * HTB, NXCD = 8, WGM = 8;

__host__ __device__ __forceinline__ int lds_byte(int r, int c) { const int st = (r >> 4) * 2 + (c >> 5), rr = r & 15, cc = c & 31, ob = rr * 64 + cc * 2; return st * 1024 + (ob ^ (((ob >> 9) & 1) << 5)); }
__host__ __device__ __forceinline__ void stage_rc(int b, int& R, int& C) { const int st = b / 1024, sb = b % 1024, swz = sb ^ (((sb >> 9) & 1) << 5); R = (st >> 1) * 16 + swz / 64; C = (st & 1) * 32 + (swz % 64) / 2; }
__host__ __device__ __forceinline__ int perm32(int rho) { const int n = rho >> 4, i = rho & 15; return 8 * (i >> 2) + 4 * n + (i & 3); }

struct Unit { int pm, pn, kt0, nkt, split; };
struct Gemm { const bf16_t* A; const bf16_t* Bt; int M, N, K; };

struct StaticOrder {
    int nM, nN, nwg, G, c, nkt;
    __host__ __device__ void init(int M, int N, int K, int G_, int c_) { nM = M / BM; nN = N / BM; nwg = nM * nN; G = G_; c = c_; nkt = K / BK; }
    __host__ __device__ bool next(int i, Unit& u) const {
        const long L = (long)i * G + c; if (L >= nwg) return false;
        int wgid = (int)L; { const int q = nwg / NXCD, r = nwg % NXCD, xcd = wgid % NXCD, off = wgid / NXCD; wgid = (xcd < r ? xcd * (q + 1) : r * (q + 1) + (xcd - r) * q) + off; }
        const int nig = WGM * nN, gid = wgid / nig, fm = gid * WGM, gsz = (nM - fm) < WGM ? (nM - fm) : WGM;
        u.pm = fm + ((wgid % nig) % gsz); u.pn = (wgid % nig) / gsz; u.kt0 = 0; u.nkt = nkt; u.split = -1; return true;
    }
    __device__ __forceinline__ void a_ready(const Unit&) const {}
    __device__ __forceinline__ void done(const Unit&) const {}
};
struct MixOrder {
    StaticOrder so; int spm, snN, nsplit, skt, scount, c0, rp;
    __device__ void init(int Mp, int N, int K, int G_, int c_, int spm_, int nsplit_) {
        so.init(Mp, N, K, G_, c_); spm = spm_; snN = N / BM; nsplit = nsplit_; skt = (K / BK) / nsplit_; scount = snN * nsplit_;
        c0 = so.nwg % G_; rp = (so.nwg - c_ + G_ - 1) / G_; if (rp < 0) rp = 0; }
    __device__ bool next(int i, Unit& u) const {
        if (i < rp) return so.next(i, u);
        const int sidx = ((so.c - c0 + so.G) % so.G) + (i - rp) * so.G; if (sidx >= scount) return false;
        const int sp = sidx / snN; u.pm = spm; u.pn = sidx - sp * snN; u.kt0 = sp * skt; u.nkt = skt; u.split = (nsplit > 1) ? sp : -1; return true; }
    __device__ __forceinline__ void a_ready(const Unit&) const {}
    __device__ __forceinline__ void done(const Unit&) const {}
};
__device__ __forceinline__ unsigned cvt_pk_bf16(float lo, float hi) { unsigned r; asm volatile("v_cvt_pk_bf16_f32 %0, %1, %2" : "=v"(r) : "v"(lo), "v"(hi)); return r; }
typedef float f32x2 __attribute__((ext_vector_type(2)));
__device__ __forceinline__ f32x2 gelu_pk(f32x2 v) {
    const f32x2 av = __builtin_elementwise_abs(v), d = av * 0.2316418882f + 1.0f;
    f32x2 t; t.x = __builtin_amdgcn_rcpf(d.x); t.y = __builtin_amdgcn_rcpf(d.y);
    f32x2 q = t * 0.5307027145f + (-0.7265760135f); q = q * t + 0.7107068705f; q = q * t + (-0.142248368f); q = q * t + 0.127414796f; q = q * t;
    const f32x2 s = (v * v) * (-0.72134752044f);
    f32x2 e; e.x = __builtin_amdgcn_exp2f(s.x); e.y = __builtin_amdgcn_exp2f(s.y);
    const f32x2 m = v * (q * e), r = v - m;
    f32x2 o; o.x = v.x < 0.f ? m.x : r.x; o.y = v.y < 0.f ? m.y : r.y; return o;
}

template <int ACT  > struct EpiBf16 {
    static constexpr bool PERM = true, AFTER_DRAIN = false; static_assert(ACT == 0 || ACT == 1, "EpiBf16: ACT is 0 (none) or 1 (gelu_pk)");
    bf16_t* O; int ldc; const float* bias; int split_cols; size_t split_stride; float scale0;
    __device__ __forceinline__ void operator()(const f32x4 (&acc)[2][2][4][2], const Unit& u, int wr, int wc, int fr, int fq) const {
        const int row0 = u.pm * BM + wr * 64 + fr; int colt = u.pn * BM; bf16_t* base = O;
        float sc = 1.f; if (split_cols) { const int t = colt / split_cols; base += (size_t)t * split_stride; colt -= t * split_cols; if (t == 0) sc = scale0; }
        const int col0 = colt + wc * 32 + 8 * fq, bcol0 = u.pn * BM + wc * 32 + 8 * fq;
        f32x4 bv[2][2];
#pragma unroll
        for (int bj = 0; bj < 2; ++bj)
#pragma unroll
            for (int n = 0; n < 2; ++n) bv[bj][n] = bias ? *(const f32x4*)(bias + bcol0 + bj * HALF + 4 * n) : (f32x4){0.f, 0.f, 0.f, 0.f};
#pragma unroll
        for (int ai = 0; ai < 2; ++ai)
#pragma unroll
            for (int m = 0; m < 4; ++m) { bf16_t* rowp = base + (size_t)(row0 + ai * HALF + m * 16) * ldc + col0;
#pragma unroll
                for (int bj = 0; bj < 2; ++bj) { f32x4 v0 = acc[ai][bj][m][0] + bv[bj][0], v1 = acc[ai][bj][m][1] + bv[bj][1];
                    if (ACT == 1) { f32x2 a = gelu_pk((f32x2){v0[0], v0[1]}), b = gelu_pk((f32x2){v0[2], v0[3]}), c = gelu_pk((f32x2){v1[0], v1[1]}), d = gelu_pk((f32x2){v1[2], v1[3]});
                        v0 = (f32x4){a.x, a.y, b.x, b.y}; v1 = (f32x4){c.x, c.y, d.x, d.y}; }
                    v0 = v0 * sc; v1 = v1 * sc; u32x4 w; w.x = cvt_pk_bf16(v0[0], v0[1]); w.y = cvt_pk_bf16(v0[2], v0[3]); w.z = cvt_pk_bf16(v1[0], v1[1]); w.w = cvt_pk_bf16(v1[2], v1[3]);
                    *(u32x4*)(rowp + bj * HALF) = w; } }
    }
};
__device__ __forceinline__ float sigmoid_f(float x) { return __builtin_amdgcn_rcpf(1.0f + __builtin_amdgcn_exp2f(-1.44269504f * x)); }
template <int MODE> struct EpiPair {
    static constexpr bool PERM = true, AFTER_DRAIN = false;
    bf16_t* O; int ldc; const float* bias; const float* RS;
    __device__ __forceinline__ void operator()(const f32x4 (&acc)[2][2][4][2], const Unit& u, int wr, int wc, int fr, int fq) const {
        const int row0 = u.pm * BM + wr * 64 + fr;
        float rs[2][4];
#pragma unroll
        for (int ai = 0; ai < 2; ++ai)
#pragma unroll
            for (int m = 0; m < 4; ++m) rs[ai][m] = RS[row0 + ai * HALF + m * 16];
        if (MODE == 2 && u.pn >= 16) {
            const int col0 = 2048 + (u.pn - 16) * BM + wc * 32 + 8 * fq;
#pragma unroll
            for (int ai = 0; ai < 2; ++ai)
#pragma unroll
                for (int m = 0; m < 4; ++m) { const int row = row0 + ai * HALF + m * 16; bf16_t* rowp = O + (size_t)row * ldc + col0;
#pragma unroll
                    for (int bj = 0; bj < 2; ++bj) { const f32x4 v0 = acc[ai][bj][m][0] * rs[ai][m], v1 = acc[ai][bj][m][1] * rs[ai][m];
                        u32x4 w; w.x = cvt_pk_bf16(v0[0], v0[1]); w.y = cvt_pk_bf16(v0[2], v0[3]); w.z = cvt_pk_bf16(v1[0], v1[1]); w.w = cvt_pk_bf16(v1[2], v1[3]);
                        *(u32x4*)(rowp + bj * HALF) = w; } }
            return;
        }
        const int oc0 = u.pn * HALF + wc * 32 + 8 * fq;
        f32x4 b0[2], b1[2];
#pragma unroll
        for (int n = 0; n < 2; ++n) { b0[n] = (MODE == 1) ? *(const f32x4*)(bias + oc0 + 4 * n) : (f32x4){0.f, 0.f, 0.f, 0.f}; b1[n] = (MODE == 1) ? *(const f32x4*)(bias + 2048 + oc0 + 4 * n) : (f32x4){0.f, 0.f, 0.f, 0.f}; }
#pragma unroll
        for (int ai = 0; ai < 2; ++ai)
#pragma unroll
            for (int m = 0; m < 4; ++m) { const int row = row0 + ai * HALF + m * 16; bf16_t* rowp = O + (size_t)row * ldc + oc0;
                f32x4 r[2];
#pragma unroll
                for (int n = 0; n < 2; ++n) { f32x4 f = acc[ai][0][m][n] * rs[ai][m], s = acc[ai][1][m][n] * rs[ai][m];
                    if (MODE == 1) { f += b0[n]; s += b1[n]; }
                    if (MODE == 2) r[n] = f * s;
                    else { const f32x4 x = (MODE == 0) ? f : s;
                        f32x4 ex = x * (-1.44269504f);
                        ex[0] = __builtin_amdgcn_exp2f(ex[0]); ex[1] = __builtin_amdgcn_exp2f(ex[1]); ex[2] = __builtin_amdgcn_exp2f(ex[2]); ex[3] = __builtin_amdgcn_exp2f(ex[3]);
                        ex = ex + 1.0f;
                        f32x4 sg; sg[0] = __builtin_amdgcn_rcpf(ex[0]); sg[1] = __builtin_amdgcn_rcpf(ex[1]); sg[2] = __builtin_amdgcn_rcpf(ex[2]); sg[3] = __builtin_amdgcn_rcpf(ex[3]);
                        r[n] = (MODE == 0) ? (f * s) * sg : f * sg; } }
                u32x4 w; w.x = cvt_pk_bf16(r[0][0], r[0][1]); w.y = cvt_pk_bf16(r[0][2], r[0][3]); w.z = cvt_pk_bf16(r[1][0], r[1][1]); w.w = cvt_pk_bf16(r[1][2], r[1][3]);
                *(u32x4*)rowp = w; }
    }
};
struct EpiGelu {
    static constexpr bool PERM = true, AFTER_DRAIN = false;
    bf16_t* O; int ldc; const float* bias; const float* RS;
    __device__ __forceinline__ void operator()(const f32x4 (&acc)[2][2][4][2], const Unit& u, int wr, int wc, int fr, int fq) const {
        const int row0 = u.pm * BM + wr * 64 + fr, col0 = u.pn * BM + wc * 32 + 8 * fq;
        float rs[2][4];
#pragma unroll
        for (int ai = 0; ai < 2; ++ai)
#pragma unroll
            for (int m = 0; m < 4; ++m) rs[ai][m] = RS[row0 + ai * HALF + m * 16];
        f32x4 bv[2][2];
#pragma unroll
        for (int bj = 0; bj < 2; ++bj)
#pragma unroll
            for (int n = 0; n < 2; ++n) bv[bj][n] = *(const f32x4*)(bias + col0 + bj * HALF + 4 * n);
#pragma unroll
        for (int ai = 0; ai < 2; ++ai)
#pragma unroll
            for (int m = 0; m < 4; ++m) { const int row = row0 + ai * HALF + m * 16; bf16_t* rowp = O + (size_t)row * ldc + col0;
#pragma unroll
                for (int bj = 0; bj < 2; ++bj) { f32x4 v0 = acc[ai][bj][m][0] * rs[ai][m] + bv[bj][0], v1 = acc[ai][bj][m][1] * rs[ai][m] + bv[bj][1];
                    const f32x2 a = gelu_pk((f32x2){v0[0], v0[1]}), b = gelu_pk((f32x2){v0[2], v0[3]}), c = gelu_pk((f32x2){v1[0], v1[1]}), d = gelu_pk((f32x2){v1[2], v1[3]});
                    u32x4 w; w.x = cvt_pk_bf16(a.x, a.y); w.y = cvt_pk_bf16(b.x, b.y); w.z = cvt_pk_bf16(c.x, c.y); w.w = cvt_pk_bf16(d.x, d.y);
                    *(u32x4*)(rowp + bj * HALF) = w; } }
    }
};
struct EpiResid {
    static constexpr bool PERM = true, AFTER_DRAIN = false;
    float* X; bf16_t* XB; float* PS; int ldc; float scale;
    __device__ __forceinline__ void operator()(const f32x4 (&acc)[2][2][4][2], const Unit& u, int wr, int wc, int fr, int fq) const {
        const int row0 = u.pm * BM + wr * 64 + fr, col0 = u.pn * BM + wc * 32 + 8 * fq, lane = fq * 16 + fr;
        f32x4 nx[2][2];
#pragma unroll
        for (int bj = 0; bj < 2; ++bj)
#pragma unroll
            for (int n = 0; n < 2; ++n) nx[bj][n] = *(const f32x4*)(X + (size_t)row0 * ldc + col0 + bj * HALF + n * 4);
#pragma unroll
        for (int g = 0; g < 8; ++g) { const int ai = g >> 2, m = g & 3, row = row0 + ai * HALF + m * 16; float* rowp = X + (size_t)row * ldc + col0; bf16_t* bp = XB + (size_t)row * ldc + col0;
            f32x4 v[2][2];
#pragma unroll
            for (int bj = 0; bj < 2; ++bj)
#pragma unroll
                for (int n = 0; n < 2; ++n) v[bj][n] = nx[bj][n];
            if (g < 7) { const int g1 = g + 1, row1 = row0 + (g1 >> 2) * HALF + (g1 & 3) * 16;
#pragma unroll
                for (int bj = 0; bj < 2; ++bj)
#pragma unroll
                    for (int n = 0; n < 2; ++n) nx[bj][n] = *(const f32x4*)(X + (size_t)row1 * ldc + col0 + bj * HALF + n * 4); }
            float ss = 0.f;
#pragma unroll
            for (int bj = 0; bj < 2; ++bj) {
#pragma unroll
                for (int n = 0; n < 2; ++n) { v[bj][n] += acc[ai][bj][m][n] * scale; *(f32x4*)(rowp + bj * HALF + n * 4) = v[bj][n];
                    ss += (v[bj][n][0] * v[bj][n][0] + v[bj][n][1] * v[bj][n][1]) + (v[bj][n][2] * v[bj][n][2] + v[bj][n][3] * v[bj][n][3]); }
                u32x4 w; w.x = cvt_pk_bf16(v[bj][0][0], v[bj][0][1]); w.y = cvt_pk_bf16(v[bj][0][2], v[bj][0][3]); w.z = cvt_pk_bf16(v[bj][1][0], v[bj][1][1]); w.w = cvt_pk_bf16(v[bj][1][2], v[bj][1][3]);
                *(u32x4*)(bp + bj * HALF) = w; }
            ss += __builtin_bit_cast(float, __builtin_amdgcn_ds_bpermute((lane ^ 16) << 2, __builtin_bit_cast(int, ss)));
            ss += __builtin_bit_cast(float, __builtin_amdgcn_ds_bpermute((lane ^ 32) << 2, __builtin_bit_cast(int, ss)));
            if (fq == 0) PS[(size_t)row * 32 + u.pn * 4 + wc] = ss; }
    }
};
template <class Base> struct EpiSlab {
    static constexpr bool PERM = Base::PERM, AFTER_DRAIN = false;
    Base base; float* slab; int N;
    __device__ __forceinline__ void operator()(const f32x4 (&acc)[2][2][4][2], const Unit& u, int wr, int wc, int fr, int fq) const {
        if (u.split < 0) { base(acc, u, wr, wc, fr, fq); return; }
        const int col0 = u.pn * BM + wc * 32 + (PERM ? 8 * fq : 4 * fq);
        float* p0 = slab + ((size_t)u.split * 128 + wr * 64 + fr) * N + col0;
#pragma unroll
        for (int m = 0; m < 4; ++m) { float* rowp = p0 + (size_t)(m * 16) * N;
#pragma unroll
            for (int bj = 0; bj < 2; ++bj)
#pragma unroll
                for (int n = 0; n < 2; ++n) *(f32x4*)(rowp + bj * HALF + (PERM ? 4 * n : 16 * n)) = acc[0][bj][m][n]; }
    }
};
template <class Epi, class Sched, bool ALIGN_EPI = false, bool SP2 = false>
__device__ __forceinline__ void gemm_phase(PG8_LAS unsigned char* lds, const Gemm g, const Sched& S, const Epi& E, int tid_in) {
    int tid_ = tid_in; asm volatile("" : "+v"(tid_));
    const int tid = tid_, wid = __builtin_amdgcn_readfirstlane(tid >> 6), lane = tid & 63, wr = wid >> 2, wc = wid & 3, fr = lane & 15, fq = lane >> 4;
    const int K = g.K;
    unsigned voffA[2], voffB[2];
#pragma unroll
    for (int i = 0; i < 2; ++i) { int R, C; stage_rc(tid * 16 + i * 8192, R, C); const int Rb = Epi::PERM ? ((R & ~31) + perm32(R & 31)) : R;
        voffA[i] = (unsigned)(R * K + C) * 2u; voffB[i] = (unsigned)(Rb * K + C) * 2u; }
    const size_t kstep = (size_t)(BK * 2);
    const size_t hstep = (size_t)HALF * K * 2;
    const size_t tstep = 2 * hstep;
    const unsigned ldsw = (unsigned)wid * 1024u;
    const int aoff = lds_byte(wr * 64 + fr, fq * 8), boff = lds_byte(wc * 32 + fr, fq * 8);
#define PG8_SA(b, h) (((b) * 2 + (h)) * HTB)
#define PG8_SB(b, h) ((4 + (b) * 2 + (h)) * HTB)
#define PG8_STAGE(bufoff, gbase, voff) do { _Pragma("unroll") for (int _i = 0; _i < 2; ++_i) \
        __builtin_amdgcn_global_load_lds((const unsigned*)((const char*)(gbase) + (voff)[_i]), (PG8_LAS unsigned*)(lds + (bufoff) + ldsw + _i * 8192), 16, 0, 0); } while (0)
#define PG8_LDA(dst, b, h) do { _Pragma("unroll") for (int m = 0; m < 4; ++m) _Pragma("unroll") for (int k = 0; k < 2; ++k) dst[m][k] = *(const PG8_LAS bf16x8*)(lds + PG8_SA(b, h) + aoff + m * 2048 + k * 1024); } while (0)
#define PG8_LDB(dst, b, h) do { _Pragma("unroll") for (int n = 0; n < 2; ++n) _Pragma("unroll") for (int k = 0; k < 2; ++k) dst[n][k] = *(const PG8_LAS bf16x8*)(lds + PG8_SB(b, h) + boff + n * 2048 + k * 1024); } while (0)
#define PG8_MMA(ai, bj, At, Bt) do { __builtin_amdgcn_s_setprio(1); _Pragma("unroll") for (int m = 0; m < 4; ++m) _Pragma("unroll") for (int n = 0; n < 2; ++n) _Pragma("unroll") for (int k = 0; k < 2; ++k) \
        acc[ai][bj][m][n] = __builtin_amdgcn_mfma_f32_16x16x32_bf16(Bt[n][k], At[m][k], acc[ai][bj][m][n], 0, 0, 0); __builtin_amdgcn_s_setprio(0); } while (0)
#define PG8_WAIT_V(n) asm volatile("s_waitcnt vmcnt(" #n ")" ::: "memory")
#define PG8_WAIT_L(n) asm volatile("s_waitcnt lgkmcnt(" #n ")" ::: "memory")
#define PG8_BAR __builtin_amdgcn_s_barrier()
#define PG8_SCHED __builtin_amdgcn_sched_barrier(0)
    Unit cur, nxt; int ui = 0;
    if (!S.next(0, cur)) return;
    f32x4 acc[2][2][4][2];
#pragma unroll
    for (int a = 0; a < 2; ++a)
#pragma unroll
        for (int b = 0; b < 2; ++b)
#pragma unroll
            for (int m = 0; m < 4; ++m)
#pragma unroll
                for (int n = 0; n < 2; ++n) acc[a][b][m][n] = (f32x4){0.f, 0.f, 0.f, 0.f};
    bf16x8 At[4][2], B0[2][2], B1[2][2];
    const char* cA = (const char*)g.A + (size_t)cur.pm * tstep + (size_t)cur.kt0 * kstep; const char* cB = (const char*)g.Bt + (size_t)cur.pn * tstep + (size_t)cur.kt0 * kstep;
    S.a_ready(cur);
    if constexpr (SP2) {
        PG8_STAGE(PG8_SB(0, 0), cB, voffB); PG8_STAGE(PG8_SB(0, 1), cB + hstep, voffB); PG8_STAGE(PG8_SA(0, 0), cA, voffA); PG8_STAGE(PG8_SA(0, 1), cA + hstep, voffA);
        if (wr == 1) PG8_BAR;
        PG8_WAIT_V(2); PG8_BAR;
        PG8_STAGE(PG8_SB(1, 0), cB + kstep, voffB); PG8_STAGE(PG8_SA(1, 0), cA + kstep, voffA); PG8_STAGE(PG8_SB(1, 1), cB + hstep + kstep, voffB);
        PG8_WAIT_V(6); PG8_BAR;
    } else {
        PG8_STAGE(PG8_SB(0, 0), cB, voffB); PG8_STAGE(PG8_SA(0, 0), cA, voffA); PG8_STAGE(PG8_SB(0, 1), cB + hstep, voffB); PG8_STAGE(PG8_SA(0, 1), cA + hstep, voffA);
        if (wr == 1) PG8_BAR;
        PG8_WAIT_V(4); PG8_BAR;
        PG8_STAGE(PG8_SB(1, 0), cB + kstep, voffB); PG8_STAGE(PG8_SA(1, 0), cA + kstep, voffA); PG8_STAGE(PG8_SB(1, 1), cB + hstep + kstep, voffB);
        PG8_WAIT_V(6); PG8_BAR;
    }
    for (;;) {
        const bool has_next = S.next(ui + 1, nxt);
        const char* nA = has_next ? (const char*)g.A + (size_t)nxt.pm * tstep + (size_t)nxt.kt0 * kstep : cA; const char* nB = has_next ? (const char*)g.Bt + (size_t)nxt.pn * tstep + (size_t)nxt.kt0 * kstep : cB;
        const int nt = cur.nkt;
        for (int t = 0; t < nt; t += 2) {
            const bool last = (t == nt - 2);
            const char* a1 = cA + (size_t)(t + 1) * kstep;
            const char* a2 = last ? nA : cA + (size_t)(t + 2) * kstep; const char* b2 = last ? nB : cB + (size_t)(t + 2) * kstep;
            const char* a3 = a2 + kstep; const char* b3 = b2 + kstep;
            if (last && has_next) S.a_ready(nxt);
            if constexpr (SP2) {
            PG8_LDB(B0, 0, 0); PG8_LDB(B1, 0, 1); PG8_SCHED; PG8_LDA(At, 0, 0); PG8_STAGE(PG8_SA(1, 1), a1 + hstep, voffA);
            PG8_WAIT_V(8); PG8_WAIT_L(0); PG8_BAR; PG8_MMA(0, 0, At, B0); PG8_MMA(0, 1, At, B1); PG8_BAR; PG8_SCHED;
            PG8_LDA(At, 0, 1); PG8_STAGE(PG8_SB(0, 0), b2, voffB); PG8_STAGE(PG8_SB(0, 1), b2 + hstep, voffB); PG8_STAGE(PG8_SA(0, 0), a2, voffA);
            PG8_WAIT_V(8); PG8_WAIT_L(0); PG8_BAR; PG8_MMA(1, 0, At, B0); PG8_MMA(1, 1, At, B1); PG8_BAR; PG8_SCHED;
            PG8_LDB(B0, 1, 0); PG8_LDB(B1, 1, 1); PG8_SCHED; PG8_LDA(At, 1, 0); PG8_STAGE(PG8_SA(0, 1), a2 + hstep, voffA);
            PG8_WAIT_V(8); PG8_WAIT_L(0); PG8_BAR; PG8_MMA(0, 0, At, B0); PG8_MMA(0, 1, At, B1); PG8_BAR; PG8_SCHED;
            PG8_LDA(At, 1, 1); PG8_STAGE(PG8_SB(1, 0), b3, voffB); PG8_STAGE(PG8_SB(1, 1), b3 + hstep, voffB); PG8_STAGE(PG8_SA(1, 0), a3, voffA);
            PG8_WAIT_V(8); PG8_WAIT_L(0); PG8_BAR; PG8_MMA(1, 0, At, B0); PG8_MMA(1, 1, At, B1); PG8_BAR; PG8_SCHED;
            } else {
            PG8_LDB(B0, 0, 0); PG8_SCHED; PG8_LDA(At, 0, 0); PG8_STAGE(PG8_SA(1, 1), a1 + hstep, voffA);
            PG8_WAIT_L(8); PG8_BAR; PG8_WAIT_L(0); PG8_MMA(0, 0, At, B0); PG8_BAR; PG8_SCHED;
            PG8_LDB(B1, 0, 1); PG8_STAGE(PG8_SB(0, 0), b2, voffB);
            PG8_BAR; PG8_WAIT_L(0); PG8_MMA(0, 1, At, B1); PG8_BAR;
            PG8_LDA(At, 0, 1); PG8_STAGE(PG8_SA(0, 0), a2, voffA);
            PG8_BAR; PG8_WAIT_L(0); PG8_MMA(1, 0, At, B0); PG8_BAR; PG8_SCHED;
            PG8_STAGE(PG8_SB(0, 1), b2 + hstep, voffB);
            PG8_WAIT_V(6); PG8_BAR; PG8_MMA(1, 1, At, B1); PG8_BAR;
            PG8_LDB(B0, 1, 0); PG8_SCHED; PG8_LDA(At, 1, 0); PG8_STAGE(PG8_SA(0, 1), a2 + hstep, voffA);
            PG8_WAIT_L(8); PG8_BAR; PG8_WAIT_L(0); PG8_MMA(0, 0, At, B0); PG8_BAR; PG8_SCHED;
            PG8_LDB(B1, 1, 1); PG8_STAGE(PG8_SB(1, 0), b3, voffB);
            PG8_BAR; PG8_WAIT_L(0); PG8_MMA(0, 1, At, B1); PG8_BAR;
            PG8_LDA(At, 1, 1); PG8_STAGE(PG8_SA(1, 0), a3, voffA);
            PG8_BAR; PG8_WAIT_L(0); PG8_MMA(1, 0, At, B0); PG8_BAR; PG8_SCHED;
            PG8_STAGE(PG8_SB(1, 1), b3 + hstep, voffB);
            PG8_WAIT_V(6); PG8_BAR; PG8_MMA(1, 1, At, B1); PG8_BAR;
            }
        }
        if constexpr (ALIGN_EPI) { if (wr == 0) PG8_BAR; }
        if constexpr (!Epi::AFTER_DRAIN) { E(acc, cur, wr, wc, fr, fq); S.done(cur); }
        if (!has_next) break;
#pragma unroll
        for (int a = 0; a < 2; ++a)
#pragma unroll
            for (int b = 0; b < 2; ++b)
#pragma unroll
                for (int m = 0; m < 4; ++m)
#pragma unroll
                    for (int n = 0; n < 2; ++n) acc[a][b][m][n] = (f32x4){0.f, 0.f, 0.f, 0.f};
        cur = nxt; cA = nA; cB = nB; ++ui;
        if constexpr (ALIGN_EPI) { if (wr == 1) PG8_BAR; }
    }
    PG8_WAIT_V(0);
    if constexpr (!ALIGN_EPI) { if (wr == 0) PG8_BAR; }
    PG8_BAR;
    if constexpr (Epi::AFTER_DRAIN) { E.fused(acc, cur, wr, wc, fr, fq, lds, wid, lane); S.done(cur); }
#undef PG8_SA
#undef PG8_SB
#undef PG8_STAGE
#undef PG8_LDA
#undef PG8_LDB
#undef PG8_MMA
#undef PG8_WAIT_V
#undef PG8_WAIT_L
#undef PG8_BAR
#undef PG8_SCHED
}
}
#define XB_TMO      128
#define XB_XCNT(j)  (256  + 64 * (j))
#define XB_XSUB(j)  (1280 + 64 * (j))
#define XB_XGEN(j)  (2304 + 64 * (j))
#define XB_TOP      3328
#define XB_TOPGEN   3392
#define XCD_BAR_WORDS 3456
#define XB_SPIN_CAP (1u << 18)

__device__ __forceinline__ unsigned xb_ld(unsigned* p)              { return __hip_atomic_load(p, __ATOMIC_RELAXED, __HIP_MEMORY_SCOPE_AGENT); }
__device__ __forceinline__ unsigned xb_add(unsigned* p, unsigned v) { return __hip_atomic_fetch_add(p, v, __ATOMIC_RELAXED, __HIP_MEMORY_SCOPE_AGENT); }
__device__ __forceinline__ unsigned xb_xcc_id() { return (unsigned)__builtin_amdgcn_s_getreg((3 << 11) | 20) & 0xFu; }
#define XB_SPIN(cond, bar) do { unsigned _sp = 0; while (cond) { __builtin_amdgcn_s_sleep(1); \
    if ((++_sp & 255u) == 0u) { if (xb_ld(&(bar)[XB_TMO])) break; if (_sp > XB_SPIN_CAP) { atomicAdd(&(bar)[XB_TMO], 1u); break; } } } } while (0)

struct XcdBarrier {
    unsigned* bar; unsigned x;
    volatile LAS unsigned* st;
};

__device__ __forceinline__ XcdBarrier xcd_barrier_post(unsigned* bar, volatile LAS unsigned* st, int tid) {
    XcdBarrier b; b.bar = bar; b.x = xb_xcc_id(); b.st = st;
    if (tid == 0) (void)xb_add(&bar[XB_XCNT(b.x)], 1u);
    return b;
}
__device__ __forceinline__ void xcd_barrier_complete(unsigned* bar, unsigned x, unsigned& nloc, unsigned& nx) {
    const unsigned G = gridDim.x * gridDim.y * gridDim.z;
    unsigned sum, cnt, mine, sp = 0u;
    for (;;) {
        sum = 0u; cnt = 0u; mine = 0u;
#pragma unroll
        for (unsigned j = 0; j < 16; ++j) { const unsigned c = xb_ld(&bar[XB_XCNT(j)]); sum += c; cnt += (c > 0u) ? 1u : 0u; mine = (j == x) ? c : mine; }
        if (sum == G) break;
        __builtin_amdgcn_s_sleep(1);
        if ((++sp & 255u) == 0u) { if (xb_ld(&bar[XB_TMO])) break; if (sp > XB_SPIN_CAP) { atomicAdd(&bar[XB_TMO], 1u); break; } }
    }
    nloc = mine > 0u ? mine : 1u; nx = cnt > 0u ? cnt : 1u;
}

__device__ __forceinline__ void xcd_barrier(const XcdBarrier& b, int tid) {
    asm volatile("s_waitcnt vmcnt(0)" ::: "memory");
    __syncthreads();
    if (tid == 0) {
        unsigned* bar = b.bar;
        __builtin_amdgcn_s_waitcnt(0);
        unsigned nloc = b.st[0], nx = b.st[1];
        if (nloc == 0u) { xcd_barrier_complete(bar, b.x, nloc, nx); b.st[0] = nloc; b.st[1] = nx; }
        const unsigned old = xb_add(&bar[XB_XSUB(b.x)], 1u);
        const unsigned gen = old / nloc;
        if (old + 1u == (gen + 1u) * nloc) {
            __builtin_amdgcn_fence(__ATOMIC_RELEASE, "agent");
            asm volatile("s_waitcnt vmcnt(0)" ::: "memory");
            const unsigned og = xb_add(&bar[XB_TOP], 1u);
            const unsigned tg = og / nx;
            if (og + 1u == (tg + 1u) * nx) xb_add(&bar[XB_TOPGEN], 1u);
            else XB_SPIN(xb_ld(&bar[XB_TOPGEN]) == tg, bar);
            __builtin_amdgcn_fence(__ATOMIC_ACQUIRE, "agent");
            xb_add(&bar[XB_XGEN(b.x)], 1u);
            asm volatile("s_waitcnt vmcnt(0)" ::: "memory");
        } else {
            XB_SPIN(xb_ld(&bar[XB_XGEN(b.x)]) == gen, bar);
            __builtin_amdgcn_fence(__ATOMIC_ACQUIRE, "agent");
            asm volatile("s_waitcnt vmcnt(0)" ::: "memory");
        }
    }
    __syncthreads();
}
constexpr int NWAVES = 8;
constexpr int D = 2048, FF = 5632, SEQ = 2048, NB = 4, NSB = 128;
constexpr int TPROMPT = NB * SEQ;
constexpr int T = TPROMPT + NSB;
constexpr int TP = 8448;
constexpr int DEPTH = 4;
constexpr float EPS = 1e-6f;
constexpr int NSPLIT_D = 22;
constexpr int CAW = 31, CCW = 3, DSGU = 4096, CHUNK = 128, NG = 8, DG = 512;
constexpr size_t O_YP = 0, O_YS = 16777216, O_AP = 17039360, O_AS = 17530880, O_VP = 33259520, O_VS = 35356672, O_CP = 35880960, O_CS = 35897344, O_END = 36421632;
constexpr size_t MiB = 1u << 20;
constexpr size_t WS_CTL = 0, CTL_ZERO_BYTES = 1 * MiB;
constexpr size_t WS_WSB = 1 * MiB;
constexpr size_t WS_WGU = 2 * MiB, SZ_WGU = 44 * MiB;
constexpr size_t WS_WD = 354 * MiB, SZ_WD = 22 * MiB;
constexpr size_t WS_WA1 = 530 * MiB, SZ_WA1 = 16 * MiB;
constexpr size_t WS_WA2 = 562 * MiB, SZ_WA2 = 8 * MiB;
constexpr size_t WS_WB1 = 578 * MiB, WS_WB2 = 610 * MiB;
constexpr size_t WS_WC1 = 626 * MiB, WS_WC2 = 650 * MiB;
constexpr size_t WS_X = 658 * MiB;
constexpr size_t WS_XN = 724 * MiB;
constexpr size_t WS_ACT = 757 * MiB;
constexpr size_t WS_Y = 889 * MiB;
constexpr size_t WS_SLAB = 955 * MiB;
constexpr size_t WS_PS = 989 * MiB;
constexpr size_t WS_RS = 991 * MiB;
constexpr size_t WS_END = 992 * MiB;
constexpr int CW_BAR = 4096;
constexpr int RING_BYTES = 131072, LDSCTL_OFF = RING_BYTES, MISC_OFF = LDSCTL_OFF + 320, LDS_BYTES = 147456;

typedef unsigned short bf16;
typedef float f32x4 __attribute__((ext_vector_type(4)));
typedef unsigned u32x4v __attribute__((ext_vector_type(4)));
typedef unsigned u32x2v __attribute__((ext_vector_type(2)));
typedef short bf16x8 __attribute__((ext_vector_type(8)));
typedef short s16x4 __attribute__((ext_vector_type(4)));
#define LDS_WAIT() asm volatile("s_waitcnt lgkmcnt(0)" ::: "memory")
#define VM_WAIT() asm volatile("s_waitcnt vmcnt(0)" ::: "memory")

__device__ __forceinline__ unsigned pk_bf16(float lo, float hi) { return pg8::cvt_pk_bf16(lo, hi); }
__device__ __forceinline__ f32x4 bf4_to_f32(u32x2v v) { f32x4 r; r.x = __uint_as_float(v.x << 16); r.y = __uint_as_float(v.x & 0xffff0000u); r.z = __uint_as_float(v.y << 16); r.w = __uint_as_float(v.y & 0xffff0000u); return r; }
__device__ __forceinline__ u32x2v f32_to_bf4(f32x4 v) { u32x2v r; r.x = pk_bf16(v.x, v.y); r.y = pk_bf16(v.z, v.w); return r; }
__device__ __forceinline__ float wave_sum(float v, int lane) {
#pragma unroll
    for (int o = 1; o < 64; o <<= 1) v += __builtin_bit_cast(float, __builtin_amdgcn_ds_bpermute((lane ^ o) << 2, __builtin_bit_cast(int, v)));
    return v;
}
__device__ __forceinline__ float silu_f(float x) { return x * pg8::sigmoid_f(x); }

struct Args { const float* in[28]; float* out; unsigned char* ws; };
typedef const __attribute__((address_space(4))) char* kargp_t;
__device__ __forceinline__ kargp_t karg_base() { kargp_t k = (kargp_t)__builtin_amdgcn_kernarg_segment_ptr(); asm volatile("" : "+s"(k)); return k; }
__device__ __forceinline__ const float* inp(int i) { return *(const float* const __attribute__((address_space(4)))*)(karg_base() + 8 * i); }
__device__ __forceinline__ float* outp() { return *(float* const __attribute__((address_space(4)))*)(karg_base() + 8 * 28); }
__device__ __forceinline__ unsigned char* wsp() { return *(unsigned char* const __attribute__((address_space(4)))*)(karg_base() + 8 * 29); }

struct Frame {
    LAS unsigned char* lds;
    int wave0;
    int tid, lane, wave, vcu, G, gw, NGW;
};

__device__ __forceinline__ int lane_id_asm() { int l; asm volatile("v_mbcnt_lo_u32_b32 %0, -1, 0\n\tv_mbcnt_hi_u32_b32 %0, -1, %0" : "=v"(l)); return l; }
__device__ __forceinline__ void relaunder(Frame& F) {
    int w = F.wave0, bx = blockIdx.x, G = gridDim.x; asm volatile("" : "+s"(w), "+s"(bx), "+s"(G));
    F.lane = lane_id_asm(); F.wave = w; F.tid = w * 64 + F.lane;
    F.G = G; F.vcu = (G % 8 == 0) ? (bx % 8) * (G / 8) + bx / 8 : bx;
    F.gw = F.vcu * NWAVES + F.wave; F.NGW = G * NWAVES;
}
__device__ __forceinline__ void transpose_item(const float* W, int ld, int K, bf16* WT, int k0, int n0, int drow0, const float* gk, LAS float* scr, int lane) {
    f32x4 v[8];
#pragma unroll
    for (int i = 0; i < 8; ++i) v[i] = *(const f32x4*)(W + (size_t)(k0 + 8 * i + (lane >> 3)) * ld + n0 + 4 * (lane & 7));
    if (gk) {
#pragma unroll
        for (int i = 0; i < 8; ++i) v[i] = v[i] * gk[k0 + 8 * i + (lane >> 3)]; }
#pragma unroll
    for (int i = 0; i < 8; ++i) { LAS float* s = scr + (8 * i + (lane >> 3)) * 33 + 4 * (lane & 7); s[0] = v[i].x; s[1] = v[i].y; s[2] = v[i].z; s[3] = v[i].w; }
    LDS_WAIT(); asm volatile("" ::: "memory");
    const int c = lane & 7;
#pragma unroll
    for (int j = 0; j < 4; ++j) { const int n = (lane >> 3) + 8 * j; const LAS float* s = scr + (8 * c) * 33 + n;
        u32x4v o; o.x = pk_bf16(s[0 * 33], s[1 * 33]); o.y = pk_bf16(s[2 * 33], s[3 * 33]); o.z = pk_bf16(s[4 * 33], s[5 * 33]); o.w = pk_bf16(s[6 * 33], s[7 * 33]);
        *(u32x4v*)(WT + (size_t)(drow0 + n) * K + k0 + 8 * c) = o; }
    LDS_WAIT(); asm volatile("" ::: "memory");
}
__device__ __forceinline__ void transpose_job(const float* W, int ld, int K, int N, bf16* WT, int mode, int roff, int item, const float* gk, LAS float* scr, int lane) {
    const int nblk = N >> 5, kb = item / nblk, nb = item - kb * nblk, n0 = nb << 5;
    const int drow0 = roff + (mode ? ((n0 >> 7) * 256 + (n0 & 127)) : n0);
    transpose_item(W, ld, K, WT, kb * 64, n0, drow0, gk, scr, lane);
}
__device__ __forceinline__ void phase_prologue(Frame& F) {
    relaunder(F);
    LAS float* scr = (LAS float*)(F.lds + F.wave * 16384);
    constexpr int I_FF = (D / 64) * (FF / 32);
    constexpr int I_A1H = (D / 64) * (D / 32);
    constexpr int I_B1 = (D / 64) * (8192 / 32);
    constexpr int I_B2 = (DSGU / 64) * (D / 32);
    constexpr int N_FFN = 8 * 3 * I_FF, N_A = 2 * 3 * I_A1H, N_B = I_B1 + I_B2, N_C = 4 * I_A1H;
    constexpr int NITEMS = N_FFN + N_A + N_B + N_C;
    unsigned char* ws = wsp();
    for (int it = F.gw; it < NITEMS; it += F.NGW) {
        int r = it;
        if (r < N_FFN) { const int f = r / (3 * I_FF), rr = r - f * 3 * I_FF, which = rr / I_FF, item = rr - which * I_FF;
            const float* gk = ((f & 1) ? inp(6) : inp(4)) + (size_t)(f >> 1) * D;
            if (which == 0)      transpose_job(inp(8) + (size_t)f * D * FF, FF, D, FF, (bf16*)(ws + WS_WGU + f * SZ_WGU), 1, 0, item, gk, scr, F.lane);
            else if (which == 1) transpose_job(inp(9) + (size_t)f * D * FF, FF, D, FF, (bf16*)(ws + WS_WGU + f * SZ_WGU), 1, 128, item, gk, scr, F.lane);
            else                 transpose_job(inp(10) + (size_t)f * FF * D, D, FF, D, (bf16*)(ws + WS_WD + f * SZ_WD), 0, 0, item, nullptr, scr, F.lane);
            continue; }
        r -= N_FFN;
        if (r < N_A) { const int j = r / (3 * I_A1H), rr = r - j * 3 * I_A1H, which = rr / I_A1H, item = rr - which * I_A1H;
            const float* gk = inp(5) + (size_t)(3 * j) * D;
            if (which == 0)      transpose_job(inp(11) + (size_t)j * D * 4096, 4096, D, D, (bf16*)(ws + WS_WA1 + j * SZ_WA1), 1, 0, item, gk, scr, F.lane);
            else if (which == 1) transpose_job(inp(11) + (size_t)j * D * 4096 + 2048, 4096, D, D, (bf16*)(ws + WS_WA1 + j * SZ_WA1), 1, 128, item, gk, scr, F.lane);
            else                 transpose_job(inp(17) + (size_t)j * D * D, D, D, D, (bf16*)(ws + WS_WA2 + j * SZ_WA2), 0, 0, item, nullptr, scr, F.lane);
            continue; }
        r -= N_A;
        if (r < N_B) {
            if (r < I_B1) transpose_job(inp(18), 8192, D, 8192, (bf16*)(ws + WS_WB1), 0, 0, r, inp(5) + (size_t)1 * D, scr, F.lane);
            else          transpose_job(inp(24), D, DSGU, D, (bf16*)(ws + WS_WB2), 0, 0, r - I_B1, nullptr, scr, F.lane);
            continue; }
        r -= N_B;
        { const int which = r / I_A1H, item = r - which * I_A1H;
            const float* gk = inp(5) + (size_t)2 * D;
            if (which == 0)      transpose_job(inp(25), 6144, D, D, (bf16*)(ws + WS_WC1), 0, 4096, item, gk, scr, F.lane);
            else if (which == 1) transpose_job(inp(25) + 2048, 6144, D, D, (bf16*)(ws + WS_WC1), 1, 0, item, gk, scr, F.lane);
            else if (which == 2) transpose_job(inp(25) + 4096, 6144, D, D, (bf16*)(ws + WS_WC1), 1, 128, item, gk, scr, F.lane);
            else                 transpose_job(inp(27), D, D, D, (bf16*)(ws + WS_WC2), 0, 0, item, nullptr, scr, F.lane); }
    }
    { const float* wsrc = inp(22); bf16* wsb = (bf16*)(ws + WS_WSB);
      for (int i = F.gw * 64 + F.lane; i < NG * CHUNK * CHUNK; i += F.NGW * 64) { const int s = i & 127, t = (i >> 7) & 127; const float v = (s <= t) ? wsrc[i] : 0.f; wsb[i] = (bf16)(pk_bf16(v, 0.f) & 0xffffu); } }
}

__device__ __forceinline__ void phase_init(Frame& F) {
    relaunder(F);
    float* X = (float*)(wsp() + WS_X); bf16* XB = (bf16*)(wsp() + WS_XN); float* RS = (float*)(wsp() + WS_RS);
    for (int m = F.gw; m < T; m += F.NGW) {
        const float* src = (m < TPROMPT) ? inp(0) + (size_t)m * D : inp(1) + (size_t)(m - TPROMPT) * D;
        f32x4 v[8]; float s = 0.f;
#pragma unroll
        for (int j = 0; j < 8; ++j) { v[j] = ((const f32x4*)src)[64 * j + F.lane]; s += (v[j].x * v[j].x + v[j].y * v[j].y) + (v[j].z * v[j].z + v[j].w * v[j].w); }
#pragma unroll
        for (int j = 0; j < 8; ++j) { ((f32x4*)(X + (size_t)m * D))[64 * j + F.lane] = v[j]; ((u32x2v*)(XB + (size_t)m * D))[64 * j + F.lane] = f32_to_bf4(v[j]); }
        const float rs = 1.0f / sqrtf(wave_sum(s, F.lane) * (1.0f / D) + EPS);
        if (F.lane == 0) RS[m] = rs;
    }
}
__device__ __forceinline__ void phase_fix(Frame& F, int nsplit, float scale) {
    relaunder(F);
    float* X = (float*)(wsp() + WS_X); bf16* XB = (bf16*)(wsp() + WS_XN); float* RS = (float*)(wsp() + WS_RS); const float* PS = (const float*)(wsp() + WS_PS);
    for (int m = F.vcu * (NWAVES * 64) + F.tid; m < TPROMPT; m += F.G * (NWAVES * 64)) {
        const f32x4* p = (const f32x4*)(PS + (size_t)m * 32); f32x4 a = p[0];
#pragma unroll
        for (int i = 1; i < 8; ++i) a += p[i];
        RS[m] = 1.0f / sqrtf(((a.x + a.y) + (a.z + a.w)) * (1.0f / D) + EPS);
    }
    LAS float* red = (LAS float*)F.lds;
    for (int bq = F.vcu; bq < NSB; bq += F.G) {
        const size_t m = TPROMPT + bq; const int c0 = 4 * F.tid;
        const float* sl = (const float*)(wsp() + WS_SLAB) + (size_t)bq * D + c0;
        f32x4 part[22];
#pragma unroll
        for (int sp = 0; sp < 22; ++sp) { part[sp] = (f32x4){0.f, 0.f, 0.f, 0.f}; if (sp < nsplit) part[sp] = *(const f32x4*)(sl + (size_t)sp * 128 * D); }
        f32x4 x = *(const f32x4*)(X + m * D + c0);
#pragma unroll
        for (int sp = 0; sp < 22; ++sp) x += part[sp] * scale;
        *(f32x4*)(X + m * D + c0) = x; *(u32x2v*)(XB + m * D + c0) = f32_to_bf4(x);
        const float s = wave_sum((x.x * x.x + x.y * x.y) + (x.z * x.z + x.w * x.w), F.lane);
        __syncthreads();
        if (F.lane == 0) red[F.wave] = s;
        __syncthreads();
        if (F.tid == 0) { float t = 0.f;
#pragma unroll
            for (int w = 0; w < NWAVES; ++w) t += red[w];
            RS[m] = 1.0f / sqrtf(t * (1.0f / D) + EPS); }
    }
}
__device__ __forceinline__ void phase_final(Frame& F) {
    relaunder(F);
    const float* X = (const float*)(wsp() + WS_X); const float* g = inp(7);
    f32x4 gv[8];
#pragma unroll
    for (int j = 0; j < 8; ++j) gv[j] = ((const f32x4*)g)[64 * j + F.lane];
    for (int m = F.gw; m < T; m += F.NGW) {
        f32x4 v[8]; float s = 0.f;
#pragma unroll
        for (int j = 0; j < 8; ++j) v[j] = ((const f32x4*)(X + (size_t)m * D))[64 * j + F.lane];
        if (m >= TPROMPT) { const float* sl = (const float*)(wsp() + WS_SLAB) + (size_t)(m - TPROMPT) * D;
#pragma unroll
            for (int j = 0; j < 8; ++j) { f32x4 p[NSPLIT_D];
#pragma unroll
                for (int sp = 0; sp < NSPLIT_D; ++sp) p[sp] = ((const f32x4*)(sl + (size_t)sp * 128 * D))[64 * j + F.lane];
#pragma unroll
                for (int sp = 0; sp < NSPLIT_D; ++sp) v[j] += p[sp] * 0.5f; } }
#pragma unroll
        for (int j = 0; j < 8; ++j) s += (v[j].x * v[j].x + v[j].y * v[j].y) + (v[j].z * v[j].z + v[j].w * v[j].w);
        const float rs = 1.0f / sqrtf(wave_sum(s, F.lane) * (1.0f / D) + EPS);
        f32x4* o = (f32x4*)(outp() + O_YP + (size_t)m * D) + F.lane;
#pragma unroll
        for (int j = 0; j < 8; ++j) o[64 * j] = (v[j] * rs) * gv[j];
    }
}

template <int R> __device__ __forceinline__ void ln_silu_store(Frame& F, f32x4 (&acc)[R], const f32x4 g, const f32x4 b, bf16* y0  , LAS float* red) {
    float s[R];
#pragma unroll
    for (int r = 0; r < R; ++r) s[r] = wave_sum((acc[r].x + acc[r].y) + (acc[r].z + acc[r].w), F.lane);
    if (F.lane == 0) {
#pragma unroll
        for (int r = 0; r < R; ++r) red[F.wave * R + r] = s[r]; }
    __syncthreads();
    float mu[R];
#pragma unroll
    for (int r = 0; r < R; ++r) { float t = 0.f;
#pragma unroll
        for (int w = 0; w < NWAVES; ++w) t += red[w * R + r];
        mu[r] = t * (1.0f / D); }
#pragma unroll
    for (int r = 0; r < R; ++r) { const f32x4 d = acc[r] - mu[r]; s[r] = wave_sum((d.x * d.x + d.y * d.y) + (d.z * d.z + d.w * d.w), F.lane); }
    LAS float* red2 = red + NWAVES * R;
    if (F.lane == 0) {
#pragma unroll
        for (int r = 0; r < R; ++r) red2[F.wave * R + r] = s[r]; }
    __syncthreads();
#pragma unroll
    for (int r = 0; r < R; ++r) { float t = 0.f;
#pragma unroll
        for (int w = 0; w < NWAVES; ++w) t += red2[w * R + r];
        const float rstd = 1.0f / sqrtf(t * (1.0f / D) + EPS);
        f32x4 y = ((acc[r] - mu[r]) * rstd) * g + b;
        y.x = silu_f(y.x); y.y = silu_f(y.y); y.z = silu_f(y.z); y.w = silu_f(y.w);
        *(u32x2v*)(y0 + (size_t)r * D) = f32_to_bf4(y); }
}
__device__ __forceinline__ void phase_convA(Frame& F, int j) {
    relaunder(F);
    const float* wdw = inp(13) + (size_t)j * CAW * D; const float* st = inp(2) + (size_t)j * NSB * 30 * D;
    const bf16* GLU = (const bf16*)(wsp() + WS_ACT); bf16* Y = (bf16*)(wsp() + WS_Y);
    LAS float* red = (LAS float*)F.lds;
    const int c0 = 4 * F.tid;
    const f32x4 bd = *(const f32x4*)(inp(14) + (size_t)j * D + c0), lg = *(const f32x4*)(inp(15) + (size_t)j * D + c0), lb = *(const f32x4*)(inp(16) + (size_t)j * D + c0);
    for (int it = F.vcu; it < TPROMPT / 8; it += F.G) {
        const int bq = it >> 8, t0 = (it & 255) * 8; const size_t m0 = (size_t)bq * SEQ + t0;
        u32x2v x[38];
#pragma unroll
        for (int i = 0; i < 38; ++i) { const int t = t0 - 30 + i; x[i] = (u32x2v){0u, 0u}; if (t >= 0) x[i] = *(const u32x2v*)(GLU + ((size_t)bq * SEQ + t) * D + c0); }
        f32x4 acc[8];
#pragma unroll
        for (int r = 0; r < 8; ++r) acc[r] = bd;
#pragma unroll
        for (int kb = 0; kb < 32; kb += 4) {
            f32x4 wk[4];
#pragma unroll
            for (int kk = 0; kk < 4; ++kk) if (kb + kk < CAW) wk[kk] = *(const f32x4*)(wdw + (size_t)(kb + kk) * D + c0);
            asm volatile("" ::: "memory");
#pragma unroll
            for (int kk = 0; kk < 4; ++kk) if (kb + kk < CAW) {
#pragma unroll
                for (int r = 0; r < 8; ++r) acc[r] += wk[kk] * bf4_to_f32(x[r + kb + kk]); }
        }
        ln_silu_store<8>(F, acc, lg, lb, Y + m0 * D + c0, red);
    }
    for (int it = F.vcu; it < NSB; it += F.G) {
        const size_t m = TPROMPT + it;
        f32x4 acc[1]; acc[0] = bd;
#pragma unroll
        for (int kb = 0; kb < 30; kb += 6) { f32x4 xs[6], wk[6];
#pragma unroll
            for (int kk = 0; kk < 6; ++kk) { xs[kk] = *(const f32x4*)(st + ((size_t)it * 30 + kb + kk) * D + c0); wk[kk] = *(const f32x4*)(wdw + (size_t)(kb + kk) * D + c0); }
            asm volatile("" ::: "memory");
#pragma unroll
            for (int kk = 0; kk < 6; ++kk) acc[0] += wk[kk] * xs[kk]; }
        { const float* sl = (const float*)(wsp() + WS_SLAB) + (size_t)it * 4096 + (c0 >> 7) * 256 + (c0 & 127);
          f32x4 av = (f32x4){0.f, 0.f, 0.f, 0.f}, gt = av; const float rs = ((const float*)(wsp() + WS_RS))[m];
#pragma unroll
          for (int sp = 0; sp < 8; ++sp) { av += *(const f32x4*)(sl + (size_t)sp * 128 * 4096); gt += *(const f32x4*)(sl + (size_t)sp * 128 * 4096 + 128); }
          av = av * rs + *(const f32x4*)(inp(12) + (size_t)j * 4096 + c0); gt = gt * rs + *(const f32x4*)(inp(12) + (size_t)j * 4096 + 2048 + c0);
          f32x4 glu; glu.x = av.x * pg8::sigmoid_f(gt.x); glu.y = av.y * pg8::sigmoid_f(gt.y); glu.z = av.z * pg8::sigmoid_f(gt.z); glu.w = av.w * pg8::sigmoid_f(gt.w);
          *(f32x4*)(outp() + O_AS + ((size_t)(j * NSB + it) * 30 + 29) * D + c0) = glu;
          acc[0] += *(const f32x4*)(wdw + (size_t)30 * D + c0) * glu; }
        ln_silu_store<1>(F, acc, lg, lb, Y + m * D + c0, red);
    }
    for (int idx = F.gw; idx < NB * 30 + NSB * 30; idx += F.NGW) {
        if (idx < NB * 30) { const int bq = idx / 30, i = idx - bq * 30; const bf16* src = GLU + ((size_t)bq * SEQ + SEQ - 30 + i) * D; float* dst = outp() + O_AP + ((size_t)(j * NB + bq) * 30 + i) * D;
#pragma unroll
            for (int q = 0; q < 8; ++q) ((f32x4*)dst)[64 * q + F.lane] = bf4_to_f32(((const u32x2v*)src)[64 * q + F.lane]); }
        else { const int r = idx - NB * 30, bq = r / 30, i = r - bq * 30; float* dst = outp() + O_AS + ((size_t)(j * NSB + bq) * 30 + i) * D;
            if (i < 29) { const float* src = st + ((size_t)bq * 30 + i + 1) * D;
#pragma unroll
                for (int q = 0; q < 8; ++q) ((f32x4*)dst)[64 * q + F.lane] = ((const f32x4*)src)[64 * q + F.lane]; }
        }
    }
}

__device__ __forceinline__ void phase_convC(Frame& F) {
    relaunder(F);
    const bf16* ACT = (const bf16*)(wsp() + WS_ACT); bf16* Y = (bf16*)(wsp() + WS_Y);
    const float* cw = inp(26); const float* st = inp(3);
    f32x4 w0[8], w1[8], w2[8];
#pragma unroll
    for (int q = 0; q < 8; ++q) { w0[q] = ((const f32x4*)cw)[64 * q + F.lane]; w1[q] = ((const f32x4*)(cw + D))[64 * q + F.lane]; w2[q] = ((const f32x4*)(cw + 2 * D))[64 * q + F.lane]; }
    for (int m = F.gw; m < T; m += F.NGW) {
        const bf16* r0 = ACT + (size_t)m * 4096;
#pragma unroll
        for (int q = 0; q < 8; ++q) {
            const int e = 64 * q + F.lane;
            f32x4 cx0, bg, cx1 = (f32x4){0.f, 0.f, 0.f, 0.f}, cx2 = (f32x4){0.f, 0.f, 0.f, 0.f};
            if (m < TPROMPT) { const int t = m & (SEQ - 1);
                cx0 = bf4_to_f32(((const u32x2v*)r0)[e]); bg = bf4_to_f32(((const u32x2v*)(r0 + 2048))[e]);
                if (t >= 1) cx1 = bf4_to_f32(((const u32x2v*)(r0 - 4096))[e]);
                if (t >= 2) cx2 = bf4_to_f32(((const u32x2v*)(r0 - 2 * 4096))[e]); }
            else { const int bq = m - TPROMPT, oc = 4 * e;
                const float* sl = (const float*)(wsp() + WS_SLAB) + (size_t)bq * 6144;
                const int colc = (oc >> 7) * 256 + (oc & 127);
                f32x4 cg = (f32x4){0.f, 0.f, 0.f, 0.f}, xi = cg; bg = cg;
#pragma unroll
                for (int sp = 0; sp < 8; ++sp) { const float* p = sl + (size_t)sp * 128 * 6144; cg += *(const f32x4*)(p + colc); xi += *(const f32x4*)(p + colc + 128); bg += *(const f32x4*)(p + 4096 + oc); }
                { const float rs = ((const float*)(wsp() + WS_RS))[m]; cx0 = (cg * rs) * (xi * rs); bg = bg * rs; }
                cx2 = ((const f32x4*)(st + ((size_t)bq * 2 + 0) * D))[e]; cx1 = ((const f32x4*)(st + ((size_t)bq * 2 + 1) * D))[e];
                ((f32x4*)(outp() + O_CS + ((size_t)bq * 2 + 1) * D))[e] = cx0; }
            const f32x4 y = bg * (w0[q] * cx2 + w1[q] * cx1 + w2[q] * cx0);
            ((u32x2v*)(Y + (size_t)m * D))[e] = f32_to_bf4(y);
        }
    }
    for (int idx = F.gw; idx < NB * 2 + NSB * 2; idx += F.NGW) {
        if (idx < NB * 2) { const int bq = idx >> 1, i = idx & 1; const bf16* src = ACT + ((size_t)bq * SEQ + SEQ - 2 + i) * 4096; float* dst = outp() + O_CP + (size_t)idx * D;
#pragma unroll
            for (int q = 0; q < 8; ++q) ((f32x4*)dst)[64 * q + F.lane] = bf4_to_f32(((const u32x2v*)src)[64 * q + F.lane]); }
        else { const int r = idx - NB * 2, bq = r >> 1, i = r & 1; float* dst = outp() + O_CS + (size_t)r * D;
            if (i == 0) { const float* src = st + ((size_t)bq * 2 + 1) * D;
#pragma unroll
                for (int q = 0; q < 8; ++q) ((f32x4*)dst)[64 * q + F.lane] = ((const f32x4*)src)[64 * q + F.lane]; }
        }
    }
}

__device__ __forceinline__ void phase_sguLN(Frame& F) {
    relaunder(F);
    bf16* Z = (bf16*)(wsp() + WS_ACT); const float* lg = inp(20); const float* lb = inp(21);
    for (int m = F.gw; m < T; m += F.NGW) {
        bf16* vr = Z + (size_t)m * 8192 + DSGU;
        f32x4 v[16]; float s = 0.f;
        if (m < TPROMPT) {
#pragma unroll
            for (int q = 0; q < 8; ++q) { const u32x4v raw = ((const u32x4v*)vr)[64 * q + F.lane];
                v[2 * q] = bf4_to_f32((u32x2v){raw.x, raw.y}); v[2 * q + 1] = bf4_to_f32((u32x2v){raw.z, raw.w}); }
        } else {
            const float* sl = (const float*)(wsp() + WS_SLAB) + (size_t)(m - TPROMPT) * 8192; const float* bias = inp(19); const float rs_s = ((const float*)(wsp() + WS_RS))[m];
#pragma unroll
            for (int half = 0; half < 2; ++half)
#pragma unroll
                for (int q = 0; q < 8; ++q) { const int col = half * DSGU + (64 * q + F.lane) * 8;
                    f32x4 a = (f32x4){0.f, 0.f, 0.f, 0.f}, b = a;
#pragma unroll
                    for (int sp = 0; sp < 8; ++sp) { a += *(const f32x4*)(sl + (size_t)sp * 128 * 8192 + col); b += *(const f32x4*)(sl + (size_t)sp * 128 * 8192 + col + 4); }
                    a = a * rs_s + *(const f32x4*)(bias + col); b = b * rs_s + *(const f32x4*)(bias + col + 4);
                    const pg8::f32x2 g0 = pg8::gelu_pk((pg8::f32x2){a.x, a.y}), g1 = pg8::gelu_pk((pg8::f32x2){a.z, a.w}), g2 = pg8::gelu_pk((pg8::f32x2){b.x, b.y}), g3 = pg8::gelu_pk((pg8::f32x2){b.z, b.w});
                    a = (f32x4){g0.x, g0.y, g1.x, g1.y}; b = (f32x4){g2.x, g2.y, g3.x, g3.y};
                    if (half == 0) { const u32x2v pa = f32_to_bf4(a), pb = f32_to_bf4(b); *(u32x4v*)(Z + (size_t)m * 8192 + col) = (u32x4v){pa.x, pa.y, pb.x, pb.y}; }
                    else { v[2 * q] = a; v[2 * q + 1] = b; } }
        }
#pragma unroll
        for (int q = 0; q < 16; ++q) s += (v[q].x + v[q].y) + (v[q].z + v[q].w);
        const float mu = wave_sum(s, F.lane) * (1.0f / DSGU); float s2 = 0.f;
#pragma unroll
        for (int q = 0; q < 16; ++q) { v[q] = v[q] - mu; s2 += (v[q].x * v[q].x + v[q].y * v[q].y) + (v[q].z * v[q].z + v[q].w * v[q].w); }
        const float rstd = 1.0f / sqrtf(wave_sum(s2, F.lane) * (1.0f / DSGU) + EPS);
        float* fo = nullptr;
        if (m >= TPROMPT) fo = outp() + O_VS + (size_t)(m - TPROMPT) * DSGU;
        else { const int t = m & (SEQ - 1); if (t >= SEQ - CHUNK) fo = outp() + O_VP + ((size_t)(m >> 11) * CHUNK + (t - (SEQ - CHUNK))) * DSGU; }
#pragma unroll
        for (int q = 0; q < 8; ++q) { const int e = (64 * q + F.lane) * 2;
            const f32x4 a = (v[2 * q] * rstd) * ((const f32x4*)lg)[e] + ((const f32x4*)lb)[e];
            const f32x4 b = (v[2 * q + 1] * rstd) * ((const f32x4*)lg)[e + 1] + ((const f32x4*)lb)[e + 1];
            const u32x2v pa = f32_to_bf4(a), pb = f32_to_bf4(b);
            ((u32x4v*)vr)[64 * q + F.lane] = (u32x4v){pa.x, pa.y, pb.x, pb.y};
            if (fo) { ((f32x4*)fo)[e] = a; ((f32x4*)fo)[e + 1] = b; } }
    }
}
__device__ __forceinline__ void phase_sguMix(Frame& F) {
    relaunder(F);
    const bf16* Z = (const bf16*)(wsp() + WS_ACT); bf16* Y = (bf16*)(wsp() + WS_Y); const bf16* WSB = (const bf16*)(wsp() + WS_WSB); const float* bs = inp(23);
    constexpr int VST = 544;
    const int l15 = F.lane & 15, g4 = F.lane >> 4;
    for (int it = F.vcu; it < 64 * NG * 2; it += F.G) {
        const int q = it >> 4, g = (it >> 1) & 7, h = it & 1; const size_t m0 = (size_t)q * CHUNK; const int colv = g * DG + h * 256;
        __syncthreads();
#pragma unroll
        for (int i = 0; i < 8; ++i) { const int idx = F.tid + 512 * i, s = idx >> 5, ch = idx & 31;
            const u32x4v raw = *(const u32x4v*)(Z + (m0 + s) * 8192 + DSGU + colv + ch * 8);
            *(LAS u32x4v*)(F.lds + s * VST + ch * 16) = raw; }
        __syncthreads();
#pragma unroll
        for (int job = 0; job < 2; ++job) {
            const int tb = job ? 7 - F.wave : F.wave, dbase = job * 8, nks = (tb + 2) >> 1;
            f32x4 acc[8];
#pragma unroll
            for (int dt = 0; dt < 8; ++dt) acc[dt] = (f32x4){0.f, 0.f, 0.f, 0.f};
            for (int ks = 0; ks < nks; ++ks) {
                const bf16* wrow = WSB + ((size_t)g * CHUNK + 16 * tb + l15) * CHUNK + 32 * ks + 4 * g4;
                const u32x2v wlo = *(const u32x2v*)wrow, whi = *(const u32x2v*)(wrow + 16);
                const bf16x8 wf = __builtin_bit_cast(bf16x8, (u32x4v){wlo.x, wlo.y, whi.x, whi.y});
                LAS unsigned char* vb = F.lds + (32 * ks + 4 * g4 + (l15 >> 2)) * VST + (16 * dbase + 4 * (l15 & 3)) * 2;
#pragma unroll
                for (int dt = 0; dt < 8; ++dt) {
                    const s16x4 lo = __builtin_bit_cast(s16x4, __builtin_amdgcn_ds_read_tr16_b64_v4i16((LAS s16x4*)(vb + dt * 32)));
                    const s16x4 hi = __builtin_bit_cast(s16x4, __builtin_amdgcn_ds_read_tr16_b64_v4i16((LAS s16x4*)(vb + dt * 32 + 16 * VST)));
                    const bf16x8 vf = (bf16x8){lo[0], lo[1], lo[2], lo[3], hi[0], hi[1], hi[2], hi[3]};
                    acc[dt] = __builtin_amdgcn_mfma_f32_16x16x32_bf16(vf, wf, acc[dt], 0, 0, 0);
                }
            }
            const int t = 16 * tb + l15; const float bias = bs[g * CHUNK + t];
#pragma unroll
            for (int dt = 0; dt < 8; ++dt) { const int col = colv + 16 * (dbase + dt) + 4 * g4;
                const f32x4 u = bf4_to_f32(*(const u32x2v*)(Z + (m0 + t) * 8192 + col));
                *(u32x2v*)(Y + (m0 + t) * DSGU + col) = f32_to_bf4(u * (acc[dt] + bias)); }
        }
    }
    const float* wsf = inp(22);
    for (int bq = F.gw; bq < NSB; bq += F.NGW) { const size_t m = TPROMPT + bq;
#pragma unroll
        for (int qq = 0; qq < 8; ++qq) { const int c = (64 * qq + F.lane) * 8, g = c >> 9; const float w00 = wsf[(size_t)g * CHUNK * CHUNK], b0 = bs[g * CHUNK];
            const u32x4v ur = *(const u32x4v*)(Z + m * 8192 + c), vr = *(const u32x4v*)(Z + m * 8192 + DSGU + c);
            const f32x4 ua = bf4_to_f32((u32x2v){ur.x, ur.y}), ub = bf4_to_f32((u32x2v){ur.z, ur.w}), va = bf4_to_f32((u32x2v){vr.x, vr.y}), vb2 = bf4_to_f32((u32x2v){vr.z, vr.w});
            const u32x2v pa = f32_to_bf4(ua * (va * w00 + b0)), pb = f32_to_bf4(ub * (vb2 * w00 + b0));
            *(u32x4v*)(Y + m * DSGU + c) = (u32x4v){pa.x, pa.y, pb.x, pb.y}; } }
}

template <class Epi> __device__ __forceinline__ void run_gemm(Frame& F, const bf16* A, const bf16* Bt, int N, int K, int nsplit, const Epi& E) {
    LAS unsigned char* lds = F.lds; relaunder(F);
    int bx = blockIdx.x, G = gridDim.x; asm volatile("" : "+s"(bx), "+s"(G));
    pg8::Gemm g{A, Bt, TP, N, K}; pg8::MixOrder S; S.init(TPROMPT, N, K, G, bx, TPROMPT / 256, nsplit);
    pg8::EpiSlab<Epi> ES{E, (float*)(wsp() + WS_SLAB), N};
    pg8::gemm_phase<pg8::EpiSlab<Epi>, pg8::MixOrder, true, true>(lds, g, S, ES, F.tid);
}
__global__ void __launch_bounds__(NWAVES * 64, 2) mk_fwd(Args args) {
    extern __shared__ __attribute__((aligned(16))) unsigned char lds_raw[];
    Frame F;
    F.lds = (LAS unsigned char*)lds_raw;
    { int w = __builtin_amdgcn_readfirstlane((int)threadIdx.x >> 6); asm volatile("" : "+s"(w)); F.wave0 = w; }
    relaunder(F);
    for (int u = F.tid; u < (LDS_BYTES - LDSCTL_OFF) / 4; u += NWAVES * 64) ((LAS unsigned*)(F.lds + LDSCTL_OFF))[u] = 0u;
    __syncthreads();
    (void)xcd_barrier_post((unsigned*)(wsp() + WS_CTL) + CW_BAR, (volatile LAS unsigned*)(F.lds + MISC_OFF) + 8, F.tid);
#define GRID_BAR() do { relaunder(F); XcdBarrier b_; b_.bar = (unsigned*)(wsp() + WS_CTL) + CW_BAR; b_.x = xb_xcc_id(); b_.st = (volatile LAS unsigned*)(F.lds + MISC_OFF) + 8; xcd_barrier(b_, F.tid); } while (0)
#define P_X   ((float*)(wsp() + WS_X))
#define P_XN  ((bf16*)(wsp() + WS_XN))
#define P_ACT ((bf16*)(wsp() + WS_ACT))
#define P_Y   ((bf16*)(wsp() + WS_Y))

    phase_prologue(F); phase_init(F); GRID_BAR();
#define P_RS  ((const float*)(wsp() + WS_RS))
#define P_PS  ((float*)(wsp() + WS_PS))
    for (int L = 0; L < DEPTH; ++L) {
        const int kind = L % 3, j = L / 3, nsp_out = (kind == 1) ? 16 : 8;
        for (int f = 0; f < 2; ++f) {
            { pg8::EpiPair<0> E{P_ACT, FF, nullptr, P_RS};
              run_gemm(F, P_XN, (const bf16*)(wsp() + WS_WGU + (size_t)(L * 2 + f) * SZ_WGU), 2 * FF, D, 1, E); }
            GRID_BAR();
            { pg8::EpiResid E{P_X, P_XN, P_PS, D, 0.5f};
              run_gemm(F, P_ACT, (const bf16*)(wsp() + WS_WD + (size_t)(L * 2 + f) * SZ_WD), D, FF, NSPLIT_D, E); }
            GRID_BAR();
            if (f == 0) {
                phase_fix(F, NSPLIT_D, 0.5f); GRID_BAR();
                const bf16* wout; int kout;
                if (kind == 0) {
                    { pg8::EpiPair<1> E{P_ACT, D, inp(12) + (size_t)j * 4096, P_RS};
                      run_gemm(F, P_XN, (const bf16*)(wsp() + WS_WA1 + (size_t)j * SZ_WA1), 4096, D, 8, E); }
                    GRID_BAR();
                    phase_convA(F, j); GRID_BAR();
                    wout = (const bf16*)(wsp() + WS_WA2 + (size_t)j * SZ_WA2); kout = D;
                } else if (kind == 1) {
                    { pg8::EpiGelu E{P_ACT, 8192, inp(19), P_RS};
                      run_gemm(F, P_XN, (const bf16*)(wsp() + WS_WB1), 8192, D, 8, E); }
                    GRID_BAR();
                    phase_sguLN(F); GRID_BAR();
                    phase_sguMix(F); GRID_BAR();
                    wout = (const bf16*)(wsp() + WS_WB2); kout = DSGU;
                } else {
                    { pg8::EpiPair<2> E{P_ACT, 4096, nullptr, P_RS};
                      run_gemm(F, P_XN, (const bf16*)(wsp() + WS_WC1), 6144, D, 8, E); }
                    GRID_BAR();
                    phase_convC(F); GRID_BAR();
                    wout = (const bf16*)(wsp() + WS_WC2); kout = D;
                }
                { pg8::EpiResid E{P_X, P_XN, P_PS, D, 1.0f};
                  run_gemm(F, P_Y, wout, D, kout, nsp_out, E); }
                GRID_BAR();
                phase_fix(F, nsp_out, 1.0f); GRID_BAR();
            } else if (L < DEPTH - 1) { phase_fix(F, NSPLIT_D, 0.5f); GRID_BAR(); }
        }
    }
    phase_final(F);
}

extern "C" void kernel_launch(void* const* d_in, const int* in_sizes, int n_in, void* d_out, int out_size, void* d_ws, size_t ws_size, hipStream_t stream) {
    static int grid = 0;
    if (grid == 0) {
        if (n_in != 28 || (size_t)out_size != O_END || ws_size < WS_END) { fprintf(stderr, "kernel_launch: unexpected shapes (n_in %d, out %d, ws %zu)\n", n_in, out_size, ws_size); grid = -1; return; }
        int dev = 0, cus = 0, per_cu = 0;
        if (hipGetDevice(&dev) != hipSuccess || hipDeviceGetAttribute(&cus, hipDeviceAttributeMultiprocessorCount, dev) != hipSuccess) { grid = -1; return; }
        if (hipFuncSetAttribute((const void*)mk_fwd, hipFuncAttributeMaxDynamicSharedMemorySize, LDS_BYTES) != hipSuccess) { fprintf(stderr, "kernel_launch: hipFuncSetAttribute failed\n"); grid = -1; return; }
        if (hipOccupancyMaxActiveBlocksPerMultiprocessor(&per_cu, (const void*)mk_fwd, NWAVES * 64, LDS_BYTES) != hipSuccess || per_cu < 1) { fprintf(stderr, "kernel_launch: occupancy query says %d\n", per_cu); }
        (void)hipGetLastError();
        grid = cus;
    }
    if (grid < 0) return;
    (void)hipMemsetAsync((char*)d_ws + WS_CTL, 0, CTL_ZERO_BYTES, stream);
    Args a{};
    for (int i = 0; i < 28; ++i) a.in[i] = (const float*)d_in[i];
    a.out = (float*)d_out; a.ws = (unsigned char*)d_ws;
    hipLaunchKernelGGL(mk_fwd, dim3(grid), dim3(NWAVES * 64), LDS_BYTES, stream, a);
}
```

```cpp
#include <hip/hip_runtime.h>
#include <cstdio>
#include <cstdint>
#define GAS __attribute__((address_space(1)))
#define LAS __attribute__((address_space(3)))
namespace pg8 {
#define PG8_LAS __attribute__((address_space(3)))
typedef unsigned short bf16_t;
typedef short bf16x8 __attribute__((ext_vector_type(8)));
typedef float f32x4 __attribute__((ext_vector_type(4)));
typedef unsigned u32x4 __attribute__((ext_vector_type(4)));
constexpr int BM = 256, BK = 64, HALF = 128, HTB = HALF * BK * 2  , STAGE_BYTES = 8 * HTB, NXCD = 8, WGM = 8;

__host__ __device__ __forceinline__ int lds_byte(int r, int c) { const int st = (r >> 4) * 2 + (c >> 5), rr = r & 15, cc = c & 31, ob = rr * 64 + cc * 2; return st * 1024 + (ob ^ (((ob >> 9) & 1) << 5)); }
__host__ __device__ __forceinline__ void stage_rc(int b, int& R, int& C) { const int st = b / 1024, sb = b % 1024, swz = sb ^ (((sb >> 9) & 1) << 5); R = (st >> 1) * 16 + swz / 64; C = (st & 1) * 32 + (swz % 64) / 2; }
__host__ __device__ __forceinline__ int perm32(int rho) { const int n = rho >> 4, i = rho & 15; return 8 * (i >> 2) + 4 * n + (i & 3); }

struct Unit { int pm, pn, kt0, nkt, split; };
struct Gemm { const bf16_t* A; const bf16_t* Bt; int M, N, K; };

struct StaticOrder {
    int nM, nN, nwg, G, c, nkt;
    __host__ __device__ void init(int M, int N, int K, int G_, int c_) { nM = M / BM; nN = N / BM; nwg = nM * nN; G = G_; c = c_; nkt = K / BK; }
    __host__ __device__ bool next(int i, Unit& u) const {
        const long L = (long)i * G + c; if (L >= nwg) return false;
        int wgid = (int)L; { const int q = nwg / NXCD, r = nwg % NXCD, xcd = wgid % NXCD, off = wgid / NXCD; wgid = (xcd < r ? xcd * (q + 1) : r * (q + 1) + (xcd - r) * q) + off; }
        const int nig = WGM * nN, gid = wgid / nig, fm = gid * WGM, gsz = (nM - fm) < WGM ? (nM - fm) : WGM;
        u.pm = fm + ((wgid % nig) % gsz); u.pn = (wgid % nig) / gsz; u.kt0 = 0; u.nkt = nkt; u.split = -1; return true;
    }
    __device__ __forceinline__ void a_ready(const Unit&) const {}
    __device__ __forceinline__ void done(const Unit&) const {}
};
struct MixOrder {
    StaticOrder so; int spm, snN, nsplit, skt, scount, c0, rp;
    __device__ void init(int Mp, int N, int K, int G_, int c_, int spm_, int nsplit_) {
        so.init(Mp, N, K, G_, c_); spm = spm_; snN = N / BM; nsplit = nsplit_; skt = (K / BK) / nsplit_; scount = snN * nsplit_;
        c0 = so.nwg % G_; rp = (so.nwg - c_ + G_ - 1) / G_; if (rp < 0) rp = 0; }
    __device__ bool next(int i, Unit& u) const {
        if (i < rp) return so.next(i, u);
        const int sidx = ((so.c - c0 + so.G) % so.G) + (i - rp) * so.G; if (sidx >= scount) return false;
        const int sp = sidx / snN; u.pm = spm; u.pn = sidx - sp * snN; u.kt0 = sp * skt; u.nkt = skt; u.split = (nsplit > 1) ? sp : -1; return true; }
    __device__ __forceinline__ void a_ready(const Unit&) const {}
    __device__ __forceinline__ void done(const Unit&) const {}
};
__device__ __forceinline__ unsigned cvt_pk_bf16(float lo, float hi) { unsigned r; asm volatile("v_cvt_pk_bf16_f32 %0, %1, %2" : "=v"(r) : "v"(lo), "v"(hi)); return r; }
typedef float f32x2 __attribute__((ext_vector_type(2)));
__device__ __forceinline__ f32x2 gelu_pk(f32x2 v) {
    const f32x2 av = __builtin_elementwise_abs(v), d = av * 0.2316418882f + 1.0f;
    f32x2 t; t.x = __builtin_amdgcn_rcpf(d.x); t.y = __builtin_amdgcn_rcpf(d.y);
    f32x2 q = t * 0.5307027145f + (-0.7265760135f); q = q * t + 0.7107068705f; q = q * t + (-0.142248368f); q = q * t + 0.127414796f; q = q * t;
    const f32x2 s = (v * v) * (-0.72134752044f);
    f32x2 e; e.x = __builtin_amdgcn_exp2f(s.x); e.y = __builtin_amdgcn_exp2f(s.y);
    const f32x2 m = v * (q * e), r = v - m;
    f32x2 o; o.x = v.x < 0.f ? m.x : r.x; o.y = v.y < 0.f ? m.y : r.y; return o;
}

template <int ACT  > struct EpiBf16 {
    static constexpr bool PERM = true, AFTER_DRAIN = false; static_assert(ACT == 0 || ACT == 1, "EpiBf16: ACT is 0 (none) or 1 (gelu_pk)");
    bf16_t* O; int ldc; const float* bias; int split_cols; size_t split_stride; float scale0;
    __device__ __forceinline__ void operator()(const f32x4 (&acc)[2][2][4][2], const Unit& u, int wr, int wc, int fr, int fq) const {
        const int row0 = u.pm * BM + wr * 64 + fr; int colt = u.pn * BM; bf16_t* base = O;
        float sc = 1.f; if (split_cols) { const int t = colt / split_cols; base += (size_t)t * split_stride; colt -= t * split_cols; if (t == 0) sc = scale0; }
        const int col0 = colt + wc * 32 + 8 * fq, bcol0 = u.pn * BM + wc * 32 + 8 * fq;
        f32x4 bv[2][2];
#pragma unroll
        for (int bj = 0; bj < 2; ++bj)
#pragma unroll
            for (int n = 0; n < 2; ++n) bv[bj][n] = bias ? *(const f32x4*)(bias + bcol0 + bj * HALF + 4 * n) : (f32x4){0.f, 0.f, 0.f, 0.f};
#pragma unroll
        for (int ai = 0; ai < 2; ++ai)
#pragma unroll
            for (int m = 0; m < 4; ++m) { bf16_t* rowp = base + (size_t)(row0 + ai * HALF + m * 16) * ldc + col0;
#pragma unroll
                for (int bj = 0; bj < 2; ++bj) { f32x4 v0 = acc[ai][bj][m][0] + bv[bj][0], v1 = acc[ai][bj][m][1] + bv[bj][1];
                    if (ACT == 1) { f32x2 a = gelu_pk((f32x2){v0[0], v0[1]}), b = gelu_pk((f32x2){v0[2], v0[3]}), c = gelu_pk((f32x2){v1[0], v1[1]}), d = gelu_pk((f32x2){v1[2], v1[3]});
                        v0 = (f32x4){a.x, a.y, b.x, b.y}; v1 = (f32x4){c.x, c.y, d.x, d.y}; }
                    v0 = v0 * sc; v1 = v1 * sc; u32x4 w; w.x = cvt_pk_bf16(v0[0], v0[1]); w.y = cvt_pk_bf16(v0[2], v0[3]); w.z = cvt_pk_bf16(v1[0], v1[1]); w.w = cvt_pk_bf16(v1[2], v1[3]);
                    *(u32x4*)(rowp + bj * HALF) = w; } }
    }
};
typedef __amdgpu_buffer_rsrc_t rsrc_t;
__device__ __forceinline__ rsrc_t mk_rsrc(const void* p) { return __builtin_amdgcn_make_buffer_rsrc((void*)p, 0, 0x7ffffff0, 0x00020000); }
__device__ __forceinline__ void st16_wt(rsrc_t r, unsigned byte_off, u32x4 v) { __builtin_amdgcn_raw_buffer_store_b128(v, r, (int)byte_off, 0, 0); }
__device__ __forceinline__ void st16_wt(rsrc_t r, unsigned byte_off, f32x4 v) { __builtin_amdgcn_raw_buffer_store_b128(__builtin_bit_cast(u32x4, v), r, (int)byte_off, 0, 0); }
__device__ __forceinline__ float sigmoid_f(float x) { return __builtin_amdgcn_rcpf(1.0f + __builtin_amdgcn_exp2f(-1.44269504f * x)); }
template <int MODE> struct EpiPair {
    static constexpr bool PERM = true, AFTER_DRAIN = false;
    bf16_t* O; int ldc; const float* bias; const float* RS;
    __device__ __forceinline__ void operator()(const f32x4 (&acc)[2][2][4][2], const Unit& u, int wr, int wc, int fr, int fq) const {
        const int row0 = u.pm * BM + wr * 64 + fr; const rsrc_t orsrc = mk_rsrc(O);
        float rs[2][4];
#pragma unroll
        for (int ai = 0; ai < 2; ++ai)
#pragma unroll
            for (int m = 0; m < 4; ++m) rs[ai][m] = RS[row0 + ai * HALF + m * 16];
        if (MODE == 2 && u.pn >= 16) {
            const int col0 = 2048 + (u.pn - 16) * BM + wc * 32 + 8 * fq;
#pragma unroll
            for (int ai = 0; ai < 2; ++ai)
#pragma unroll
                for (int m = 0; m < 4; ++m) { const int row = row0 + ai * HALF + m * 16; const unsigned ob = (unsigned)(row * ldc + col0) * 2u;
#pragma unroll
                    for (int bj = 0; bj < 2; ++bj) { const f32x4 v0 = acc[ai][bj][m][0] * rs[ai][m], v1 = acc[ai][bj][m][1] * rs[ai][m];
                        u32x4 w; w.x = cvt_pk_bf16(v0[0], v0[1]); w.y = cvt_pk_bf16(v0[2], v0[3]); w.z = cvt_pk_bf16(v1[0], v1[1]); w.w = cvt_pk_bf16(v1[2], v1[3]);
                        st16_wt(orsrc, ob + bj * HALF * 2, w); } }
            return;
        }
        const int oc0 = u.pn * HALF + wc * 32 + 8 * fq;
        f32x4 b0[2], b1[2];
#pragma unroll
        for (int n = 0; n < 2; ++n) { b0[n] = (MODE == 1) ? *(const f32x4*)(bias + oc0 + 4 * n) : (f32x4){0.f, 0.f, 0.f, 0.f}; b1[n] = (MODE == 1) ? *(const f32x4*)(bias + 2048 + oc0 + 4 * n) : (f32x4){0.f, 0.f, 0.f, 0.f}; }
#pragma unroll
        for (int ai = 0; ai < 2; ++ai)
#pragma unroll
            for (int m = 0; m < 4; ++m) { const int row = row0 + ai * HALF + m * 16; const unsigned ob = (unsigned)(row * ldc + oc0) * 2u;
                f32x4 r[2];
#pragma unroll
                for (int n = 0; n < 2; ++n) { f32x4 f = acc[ai][0][m][n] * rs[ai][m], s = acc[ai][1][m][n] * rs[ai][m];
                    if (MODE == 1) { f += b0[n]; s += b1[n]; }
                    if (MODE == 2) r[n] = f * s;
                    else { const f32x4 x = (MODE == 0) ? f : s;
                        f32x4 ex = x * (-1.44269504f);
                        ex[0] = __builtin_amdgcn_exp2f(ex[0]); ex[1] = __builtin_amdgcn_exp2f(ex[1]); ex[2] = __builtin_amdgcn_exp2f(ex[2]); ex[3] = __builtin_amdgcn_exp2f(ex[3]);
                        ex = ex + 1.0f;
                        f32x4 sg; sg[0] = __builtin_amdgcn_rcpf(ex[0]); sg[1] = __builtin_amdgcn_rcpf(ex[1]); sg[2] = __builtin_amdgcn_rcpf(ex[2]); sg[3] = __builtin_amdgcn_rcpf(ex[3]);
                        r[n] = (MODE == 0) ? (f * s) * sg : f * sg; } }
                u32x4 w; w.x = cvt_pk_bf16(r[0][0], r[0][1]); w.y = cvt_pk_bf16(r[0][2], r[0][3]); w.z = cvt_pk_bf16(r[1][0], r[1][1]); w.w = cvt_pk_bf16(r[1][2], r[1][3]);
                st16_wt(orsrc, ob, w); }
    }
};
struct EpiGelu {
    static constexpr bool PERM = true, AFTER_DRAIN = false;
    bf16_t* O; int ldc; const float* bias; const float* RS;
    __device__ __forceinline__ void operator()(const f32x4 (&acc)[2][2][4][2], const Unit& u, int wr, int wc, int fr, int fq) const {
        const int row0 = u.pm * BM + wr * 64 + fr, col0 = u.pn * BM + wc * 32 + 8 * fq; const rsrc_t orsrc = mk_rsrc(O);
        float rs[2][4];
#pragma unroll
        for (int ai = 0; ai < 2; ++ai)
#pragma unroll
            for (int m = 0; m < 4; ++m) rs[ai][m] = RS[row0 + ai * HALF + m * 16];
        f32x4 bv[2][2];
#pragma unroll
        for (int bj = 0; bj < 2; ++bj)
#pragma unroll
            for (int n = 0; n < 2; ++n) bv[bj][n] = *(const f32x4*)(bias + col0 + bj * HALF + 4 * n);
#pragma unroll
        for (int ai = 0; ai < 2; ++ai)
#pragma unroll
            for (int m = 0; m < 4; ++m) { const int row = row0 + ai * HALF + m * 16; const unsigned ob = (unsigned)(row * ldc + col0) * 2u;
#pragma unroll
                for (int bj = 0; bj < 2; ++bj) { f32x4 v0 = acc[ai][bj][m][0] * rs[ai][m] + bv[bj][0], v1 = acc[ai][bj][m][1] * rs[ai][m] + bv[bj][1];
                    const f32x2 a = gelu_pk((f32x2){v0[0], v0[1]}), b = gelu_pk((f32x2){v0[2], v0[3]}), c = gelu_pk((f32x2){v1[0], v1[1]}), d = gelu_pk((f32x2){v1[2], v1[3]});
                    u32x4 w; w.x = cvt_pk_bf16(a.x, a.y); w.y = cvt_pk_bf16(b.x, b.y); w.z = cvt_pk_bf16(c.x, c.y); w.w = cvt_pk_bf16(d.x, d.y);
                    st16_wt(orsrc, ob + bj * HALF * 2, w); } }
    }
};
struct EpiResid {
    static constexpr bool PERM = true, AFTER_DRAIN = false;
    float* X; bf16_t* XB; float* PS; int ldc; float scale;
    __device__ __forceinline__ void operator()(const f32x4 (&acc)[2][2][4][2], const Unit& u, int wr, int wc, int fr, int fq) const {
        const int row0 = u.pm * BM + wr * 64 + fr, col0 = u.pn * BM + wc * 32 + 8 * fq, lane = fq * 16 + fr; const rsrc_t xr = mk_rsrc(X), br = mk_rsrc(XB);
        f32x4 nx[2][2];
#pragma unroll
        for (int bj = 0; bj < 2; ++bj)
#pragma unroll
            for (int n = 0; n < 2; ++n) nx[bj][n] = *(const f32x4*)(X + (size_t)row0 * ldc + col0 + bj * HALF + n * 4);
#pragma unroll
        for (int g = 0; g < 8; ++g) { const int ai = g >> 2, m = g & 3, row = row0 + ai * HALF + m * 16; const unsigned eo = (unsigned)(row * ldc + col0);
            f32x4 v[2][2];
#pragma unroll
            for (int bj = 0; bj < 2; ++bj)
#pragma unroll
                for (int n = 0; n < 2; ++n) v[bj][n] = nx[bj][n];
            if (g < 7) { const int g1 = g + 1, row1 = row0 + (g1 >> 2) * HALF + (g1 & 3) * 16;
#pragma unroll
                for (int bj = 0; bj < 2; ++bj)
#pragma unroll
                    for (int n = 0; n < 2; ++n) nx[bj][n] = *(const f32x4*)(X + (size_t)row1 * ldc + col0 + bj * HALF + n * 4); }
            float ss = 0.f;
#pragma unroll
            for (int bj = 0; bj < 2; ++bj) {
#pragma unroll
                for (int n = 0; n < 2; ++n) { v[bj][n] += acc[ai][bj][m][n] * scale; st16_wt(xr, (eo + bj * HALF + n * 4) * 4u, v[bj][n]);
                    ss += (v[bj][n][0] * v[bj][n][0] + v[bj][n][1] * v[bj][n][1]) + (v[bj][n][2] * v[bj][n][2] + v[bj][n][3] * v[bj][n][3]); }
                u32x4 w; w.x = cvt_pk_bf16(v[bj][0][0], v[bj][0][1]); w.y = cvt_pk_bf16(v[bj][0][2], v[bj][0][3]); w.z = cvt_pk_bf16(v[bj][1][0], v[bj][1][1]); w.w = cvt_pk_bf16(v[bj][1][2], v[bj][1][3]);
                st16_wt(br, (eo + bj * HALF) * 2u, w); }
            ss += __builtin_bit_cast(float, __builtin_amdgcn_ds_bpermute((lane ^ 16) << 2, __builtin_bit_cast(int, ss)));
            ss += __builtin_bit_cast(float, __builtin_amdgcn_ds_bpermute((lane ^ 32) << 2, __builtin_bit_cast(int, ss)));
            if (fq == 0) PS[(size_t)row * 32 + u.pn * 4 + wc] = ss; }
    }
};
template <class Base> struct EpiSlab {
    static constexpr bool PERM = Base::PERM, AFTER_DRAIN = false;
    Base base; float* slab; int N;
    __device__ __forceinline__ void operator()(const f32x4 (&acc)[2][2][4][2], const Unit& u, int wr, int wc, int fr, int fq) const {
        if (u.split < 0) { base(acc, u, wr, wc, fr, fq); return; }
        const int col0 = u.pn * BM + wc * 32 + (PERM ? 8 * fq : 4 * fq);
        const rsrc_t sr = mk_rsrc(slab); const unsigned e0 = (unsigned)((u.split * 128 + wr * 64 + fr) * N + col0);
#pragma unroll
        for (int m = 0; m < 4; ++m) {
#pragma unroll
            for (int bj = 0; bj < 2; ++bj)
#pragma unroll
                for (int n = 0; n < 2; ++n) st16_wt(sr, (e0 + (unsigned)(m * 16 * N) + bj * HALF + (PERM ? 4 * n : 16 * n)) * 4u, acc[0][bj][m][n]); }
    }
};
template <class Epi, class Sched, bool ALIGN_EPI = false, bool SP2 = false>
__device__ __forceinline__ void gemm_phase(PG8_LAS unsigned char* lds, const Gemm g, const Sched& S, const Epi& E, int tid_in) {
    int tid_ = tid_in; asm volatile("" : "+v"(tid_));
    const int tid = tid_, wid = __builtin_amdgcn_readfirstlane(tid >> 6), lane = tid & 63, wr = wid >> 2, wc = wid & 3, fr = lane & 15, fq = lane >> 4;
    const int K = g.K;
    unsigned voffA[2], voffB[2];
#pragma unroll
    for (int i = 0; i < 2; ++i) { int R, C; stage_rc(tid * 16 + i * 8192, R, C); const int Rb = Epi::PERM ? ((R & ~31) + perm32(R & 31)) : R;
        voffA[i] = (unsigned)(R * K + C) * 2u; voffB[i] = (unsigned)(Rb * K + C) * 2u; }
    const size_t kstep = (size_t)(BK * 2);
    const size_t hstep = (size_t)HALF * K * 2;
    const size_t tstep = 2 * hstep;
    const unsigned ldsw = (unsigned)wid * 1024u;
    const int aoff = lds_byte(wr * 64 + fr, fq * 8), boff = lds_byte(wc * 32 + fr, fq * 8);
#define PG8_SA(b, h) (((b) * 2 + (h)) * HTB)
#define PG8_SB(b, h) ((4 + (b) * 2 + (h)) * HTB)
#define PG8_STAGE(bufoff, gbase, voff) do { _Pragma("unroll") for (int _i = 0; _i < 2; ++_i) \
        __builtin_amdgcn_global_load_lds((const unsigned*)((const char*)(gbase) + (voff)[_i]), (PG8_LAS unsigned*)(lds + (bufoff) + ldsw + _i * 8192), 16, 0, 0); } while (0)
#define PG8_LDA(dst, b, h) do { _Pragma("unroll") for (int m = 0; m < 4; ++m) _Pragma("unroll") for (int k = 0; k < 2; ++k) dst[m][k] = *(const PG8_LAS bf16x8*)(lds + PG8_SA(b, h) + aoff + m * 2048 + k * 1024); } while (0)
#define PG8_LDB(dst, b, h) do { _Pragma("unroll") for (int n = 0; n < 2; ++n) _Pragma("unroll") for (int k = 0; k < 2; ++k) dst[n][k] = *(const PG8_LAS bf16x8*)(lds + PG8_SB(b, h) + boff + n * 2048 + k * 1024); } while (0)
#define PG8_MMA(ai, bj, At, Bt) do { __builtin_amdgcn_s_setprio(1); _Pragma("unroll") for (int m = 0; m < 4; ++m) _Pragma("unroll") for (int n = 0; n < 2; ++n) _Pragma("unroll") for (int k = 0; k < 2; ++k) \
        acc[ai][bj][m][n] = __builtin_amdgcn_mfma_f32_16x16x32_bf16(Bt[n][k], At[m][k], acc[ai][bj][m][n], 0, 0, 0); __builtin_amdgcn_s_setprio(0); } while (0)
#define PG8_WAIT_V(n) asm volatile("s_waitcnt vmcnt(" #n ")" ::: "memory")
#define PG8_WAIT_L(n) asm volatile("s_waitcnt lgkmcnt(" #n ")" ::: "memory")
#define PG8_BAR __builtin_amdgcn_s_barrier()
#define PG8_SCHED __builtin_amdgcn_sched_barrier(0)
    Unit cur, nxt; int ui = 0;
    if (!S.next(0, cur)) return;
    f32x4 acc[2][2][4][2];
#pragma unroll
    for (int a = 0; a < 2; ++a)
#pragma unroll
        for (int b = 0; b < 2; ++b)
#pragma unroll
            for (int m = 0; m < 4; ++m)
#pragma unroll
                for (int n = 0; n < 2; ++n) acc[a][b][m][n] = (f32x4){0.f, 0.f, 0.f, 0.f};
    bf16x8 At[4][2], B0[2][2], B1[2][2];
    const char* cA = (const char*)g.A + (size_t)cur.pm * tstep + (size_t)cur.kt0 * kstep; const char* cB = (const char*)g.Bt + (size_t)cur.pn * tstep + (size_t)cur.kt0 * kstep;
    S.a_ready(cur);
    if constexpr (SP2) {
        PG8_STAGE(PG8_SB(0, 0), cB, voffB); PG8_STAGE(PG8_SB(0, 1), cB + hstep, voffB); PG8_STAGE(PG8_SA(0, 0), cA, voffA); PG8_STAGE(PG8_SA(0, 1), cA + hstep, voffA);
        if (wr == 1) PG8_BAR;
        PG8_WAIT_V(2); PG8_BAR;
        PG8_STAGE(PG8_SB(1, 0), cB + kstep, voffB); PG8_STAGE(PG8_SA(1, 0), cA + kstep, voffA); PG8_STAGE(PG8_SB(1, 1), cB + hstep + kstep, voffB);
        PG8_WAIT_V(6); PG8_BAR;
    } else {
        PG8_STAGE(PG8_SB(0, 0), cB, voffB); PG8_STAGE(PG8_SA(0, 0), cA, voffA); PG8_STAGE(PG8_SB(0, 1), cB + hstep, voffB); PG8_STAGE(PG8_SA(0, 1), cA + hstep, voffA);
        if (wr == 1) PG8_BAR;
        PG8_WAIT_V(4); PG8_BAR;
        PG8_STAGE(PG8_SB(1, 0), cB + kstep, voffB); PG8_STAGE(PG8_SA(1, 0), cA + kstep, voffA); PG8_STAGE(PG8_SB(1, 1), cB + hstep + kstep, voffB);
        PG8_WAIT_V(6); PG8_BAR;
    }
    for (;;) {
        const bool has_next = S.next(ui + 1, nxt);
        const char* nA = has_next ? (const char*)g.A + (size_t)nxt.pm * tstep + (size_t)nxt.kt0 * kstep : cA; const char* nB = has_next ? (const char*)g.Bt + (size_t)nxt.pn * tstep + (size_t)nxt.kt0 * kstep : cB;
        const int nt = cur.nkt;
        for (int t = 0; t < nt; t += 2) {
            const bool last = (t == nt - 2);
            const char* a1 = cA + (size_t)(t + 1) * kstep;
            const char* a2 = last ? nA : cA + (size_t)(t + 2) * kstep; const char* b2 = last ? nB : cB + (size_t)(t + 2) * kstep;
            const char* a3 = a2 + kstep; const char* b3 = b2 + kstep;
            if (last && has_next) S.a_ready(nxt);
            if constexpr (SP2) {
            PG8_LDB(B0, 0, 0); PG8_LDB(B1, 0, 1); PG8_SCHED; PG8_LDA(At, 0, 0); PG8_STAGE(PG8_SA(1, 1), a1 + hstep, voffA);
            PG8_WAIT_V(8); PG8_WAIT_L(0); PG8_BAR; PG8_MMA(0, 0, At, B0); PG8_MMA(0, 1, At, B1); PG8_BAR; PG8_SCHED;
            PG8_LDA(At, 0, 1); PG8_STAGE(PG8_SB(0, 0), b2, voffB); PG8_STAGE(PG8_SB(0, 1), b2 + hstep, voffB); PG8_STAGE(PG8_SA(0, 0), a2, voffA);
            PG8_WAIT_V(8); PG8_WAIT_L(0); PG8_BAR; PG8_MMA(1, 0, At, B0); PG8_MMA(1, 1, At, B1); PG8_BAR; PG8_SCHED;
            PG8_LDB(B0, 1, 0); PG8_LDB(B1, 1, 1); PG8_SCHED; PG8_LDA(At, 1, 0); PG8_STAGE(PG8_SA(0, 1), a2 + hstep, voffA);
            PG8_WAIT_V(8); PG8_WAIT_L(0); PG8_BAR; PG8_MMA(0, 0, At, B0); PG8_MMA(0, 1, At, B1); PG8_BAR; PG8_SCHED;
            PG8_LDA(At, 1, 1); PG8_STAGE(PG8_SB(1, 0), b3, voffB); PG8_STAGE(PG8_SB(1, 1), b3 + hstep, voffB); PG8_STAGE(PG8_SA(1, 0), a3, voffA);
            PG8_WAIT_V(8); PG8_WAIT_L(0); PG8_BAR; PG8_MMA(1, 0, At, B0); PG8_MMA(1, 1, At, B1); PG8_BAR; PG8_SCHED;
            } else {
            PG8_LDB(B0, 0, 0); PG8_SCHED; PG8_LDA(At, 0, 0); PG8_STAGE(PG8_SA(1, 1), a1 + hstep, voffA);
            PG8_WAIT_L(8); PG8_BAR; PG8_WAIT_L(0); PG8_MMA(0, 0, At, B0); PG8_BAR; PG8_SCHED;
            PG8_LDB(B1, 0, 1); PG8_STAGE(PG8_SB(0, 0), b2, voffB);
            PG8_BAR; PG8_WAIT_L(0); PG8_MMA(0, 1, At, B1); PG8_BAR;
            PG8_LDA(At, 0, 1); PG8_STAGE(PG8_SA(0, 0), a2, voffA);
            PG8_BAR; PG8_WAIT_L(0); PG8_MMA(1, 0, At, B0); PG8_BAR; PG8_SCHED;
            PG8_STAGE(PG8_SB(0, 1), b2 + hstep, voffB);
            PG8_WAIT_V(6); PG8_BAR; PG8_MMA(1, 1, At, B1); PG8_BAR;
            PG8_LDB(B0, 1, 0); PG8_SCHED; PG8_LDA(At, 1, 0); PG8_STAGE(PG8_SA(0, 1), a2 + hstep, voffA);
            PG8_WAIT_L(8); PG8_BAR; PG8_WAIT_L(0); PG8_MMA(0, 0, At, B0); PG8_BAR; PG8_SCHED;
            PG8_LDB(B1, 1, 1); PG8_STAGE(PG8_SB(1, 0), b3, voffB);
            PG8_BAR; PG8_WAIT_L(0); PG8_MMA(0, 1, At, B1); PG8_BAR;
            PG8_LDA(At, 1, 1); PG8_STAGE(PG8_SA(1, 0), a3, voffA);
            PG8_BAR; PG8_WAIT_L(0); PG8_MMA(1, 0, At, B0); PG8_BAR; PG8_SCHED;
            PG8_STAGE(PG8_SB(1, 1), b3 + hstep, voffB);
            PG8_WAIT_V(6); PG8_BAR; PG8_MMA(1, 1, At, B1); PG8_BAR;
            }
        }
        if constexpr (ALIGN_EPI) { if (wr == 0) PG8_BAR; }
        if constexpr (!Epi::AFTER_DRAIN) { E(acc, cur, wr, wc, fr, fq); S.done(cur); }
        if (!has_next) break;
#pragma unroll
        for (int a = 0; a < 2; ++a)
#pragma unroll
            for (int b = 0; b < 2; ++b)
#pragma unroll
                for (int m = 0; m < 4; ++m)
#pragma unroll
                    for (int n = 0; n < 2; ++n) acc[a][b][m][n] = (f32x4){0.f, 0.f, 0.f, 0.f};
        cur = nxt; cA = nA; cB = nB; ++ui;
        if constexpr (ALIGN_EPI) { if (wr == 1) PG8_BAR; }
    }
    PG8_WAIT_V(0);
    if constexpr (!ALIGN_EPI) { if (wr == 0) PG8_BAR; }
    PG8_BAR;
    if constexpr (Epi::AFTER_DRAIN) { E.fused(acc, cur, wr, wc, fr, fq, lds, wid, lane); S.done(cur); }
#undef PG8_SA
#undef PG8_SB
#undef PG8_STAGE
#undef PG8_LDA
#undef PG8_LDB
#undef PG8_MMA
#undef PG8_WAIT_V
#undef PG8_WAIT_L
#undef PG8_BAR
#undef PG8_SCHED
}
}
#define XB_TMO      128
#define XB_XCNT(j)  (256  + 64 * (j))
#define XB_XSUB(j)  (1280 + 64 * (j))
#define XB_XGEN(j)  (2304 + 64 * (j))
#define XB_TOP      3328
#define XB_TOPGEN   3392
#define XCD_BAR_WORDS 3456
#define XB_SPIN_CAP (1u << 18)

__device__ __forceinline__ unsigned xb_ld(unsigned* p)              { return __hip_atomic_load(p, __ATOMIC_RELAXED, __HIP_MEMORY_SCOPE_AGENT); }
__device__ __forceinline__ unsigned xb_add(unsigned* p, unsigned v) { return __hip_atomic_fetch_add(p, v, __ATOMIC_RELAXED, __HIP_MEMORY_SCOPE_AGENT); }
__device__ __forceinline__ unsigned xb_xcc_id() { return (unsigned)__builtin_amdgcn_s_getreg((3 << 11) | 20) & 0xFu; }
#define XB_SPIN(cond, bar) do { unsigned _sp = 0; while (cond) { __builtin_amdgcn_s_sleep(1); \
    if ((++_sp & 255u) == 0u) { if (xb_ld(&(bar)[XB_TMO])) break; if (_sp > XB_SPIN_CAP) { atomicAdd(&(bar)[XB_TMO], 1u); break; } } } } while (0)

struct XcdBarrier {
    unsigned* bar; unsigned x;
    volatile LAS unsigned* st;
};

__device__ __forceinline__ XcdBarrier xcd_barrier_post(unsigned* bar, volatile LAS unsigned* st, int tid) {
    XcdBarrier b; b.bar = bar; b.x = xb_xcc_id(); b.st = st;
    if (tid == 0) (void)xb_add(&bar[XB_XCNT(b.x)], 1u);
    return b;
}
__device__ __forceinline__ void xcd_barrier_complete(unsigned* bar, unsigned x, unsigned& nloc, unsigned& nx) {
    const unsigned G = gridDim.x * gridDim.y * gridDim.z;
    unsigned sum, cnt, mine, sp = 0u;
    for (;;) {
        sum = 0u; cnt = 0u; mine = 0u;
#pragma unroll
        for (unsigned j = 0; j < 16; ++j) { const unsigned c = xb_ld(&bar[XB_XCNT(j)]); sum += c; cnt += (c > 0u) ? 1u : 0u; mine = (j == x) ? c : mine; }
        if (sum == G) break;
        __builtin_amdgcn_s_sleep(1);
        if ((++sp & 255u) == 0u) { if (xb_ld(&bar[XB_TMO])) break; if (sp > XB_SPIN_CAP) { atomicAdd(&bar[XB_TMO], 1u); break; } }
    }
    nloc = mine > 0u ? mine : 1u; nx = cnt > 0u ? cnt : 1u;
}

__device__ __forceinline__ void xcd_barrier(const XcdBarrier& b, int tid) {
    asm volatile("s_waitcnt vmcnt(0)" ::: "memory");
    __syncthreads();
    if (tid == 0) {
        unsigned* bar = b.bar;
        __builtin_amdgcn_s_waitcnt(0);
        unsigned nloc = b.st[0], nx = b.st[1];
        if (nloc == 0u) { xcd_barrier_complete(bar, b.x, nloc, nx); b.st[0] = nloc; b.st[1] = nx; }
        const unsigned old = xb_add(&bar[XB_XSUB(b.x)], 1u);
        const unsigned gen = old / nloc;
        if (old + 1u == (gen + 1u) * nloc) {
            __builtin_amdgcn_fence(__ATOMIC_RELEASE, "agent");
            asm volatile("s_waitcnt vmcnt(0)" ::: "memory");
            const unsigned og = xb_add(&bar[XB_TOP], 1u);
            const unsigned tg = og / nx;
            if (og + 1u == (tg + 1u) * nx) xb_add(&bar[XB_TOPGEN], 1u);
            else XB_SPIN(xb_ld(&bar[XB_TOPGEN]) == tg, bar);
            __builtin_amdgcn_fence(__ATOMIC_ACQUIRE, "agent");
            xb_add(&bar[XB_XGEN(b.x)], 1u);
            asm volatile("s_waitcnt vmcnt(0)" ::: "memory");
        } else {
            XB_SPIN(xb_ld(&bar[XB_XGEN(b.x)]) == gen, bar);
            __builtin_amdgcn_fence(__ATOMIC_ACQUIRE, "agent");
            asm volatile("s_waitcnt vmcnt(0)" ::: "memory");
        }
    }
    __syncthreads();
}
constexpr int NWAVES = 8;
constexpr int D = 2048, FF = 5632, SEQ = 2048, NB = 4, NSB = 128;
constexpr int TPROMPT = NB * SEQ;
constexpr int T = TPROMPT + NSB;
constexpr int TP = 8448;
constexpr int DEPTH = 4;
constexpr float EPS = 1e-6f;
constexpr int NSPLIT_D = 22;
constexpr int CAW = 31, CCW = 3, DSGU = 4096, CHUNK = 128, NG = 8, DG = 512;
constexpr size_t O_YP = 0, O_YS = 16777216, O_AP = 17039360, O_AS = 17530880, O_VP = 33259520, O_VS = 35356672, O_CP = 35880960, O_CS = 35897344, O_END = 36421632;
constexpr size_t MiB = 1u << 20;
constexpr size_t WS_CTL = 0, CTL_ZERO_BYTES = 1 * MiB;
constexpr size_t WS_WSB = 1 * MiB;
constexpr size_t WS_WGU = 2 * MiB, SZ_WGU = 44 * MiB;
constexpr size_t WS_WD = 354 * MiB, SZ_WD = 22 * MiB;
constexpr size_t WS_WA1 = 530 * MiB, SZ_WA1 = 16 * MiB;
constexpr size_t WS_WA2 = 562 * MiB, SZ_WA2 = 8 * MiB;
constexpr size_t WS_WB1 = 578 * MiB, WS_WB2 = 610 * MiB;
constexpr size_t WS_WC1 = 626 * MiB, WS_WC2 = 650 * MiB;
constexpr size_t WS_X = 658 * MiB;
constexpr size_t WS_XN = 724 * MiB;
constexpr size_t WS_ACT = 757 * MiB;
constexpr size_t WS_Y = 889 * MiB;
constexpr size_t WS_SLAB = 955 * MiB;
constexpr size_t WS_PS = 989 * MiB;
constexpr size_t WS_RS = 991 * MiB;
constexpr size_t WS_END = 992 * MiB;
constexpr int CW_BAR = 4096;
constexpr int RING_BYTES = 131072, LDSCTL_OFF = RING_BYTES, MISC_OFF = LDSCTL_OFF + 320, LDS_BYTES = 147456;

typedef unsigned short bf16;
typedef float f32x4 __attribute__((ext_vector_type(4)));
typedef unsigned u32x4v __attribute__((ext_vector_type(4)));
typedef unsigned u32x2v __attribute__((ext_vector_type(2)));
typedef short bf16x8 __attribute__((ext_vector_type(8)));
typedef short s16x4 __attribute__((ext_vector_type(4)));
#define LDS_WAIT() asm volatile("s_waitcnt lgkmcnt(0)" ::: "memory")
#define VM_WAIT() asm volatile("s_waitcnt vmcnt(0)" ::: "memory")

__device__ __forceinline__ unsigned pk_bf16(float lo, float hi) { return pg8::cvt_pk_bf16(lo, hi); }
__device__ __forceinline__ f32x4 bf4_to_f32(u32x2v v) { f32x4 r; r.x = __uint_as_float(v.x << 16); r.y = __uint_as_float(v.x & 0xffff0000u); r.z = __uint_as_float(v.y << 16); r.w = __uint_as_float(v.y & 0xffff0000u); return r; }
__device__ __forceinline__ u32x2v f32_to_bf4(f32x4 v) { u32x2v r; r.x = pk_bf16(v.x, v.y); r.y = pk_bf16(v.z, v.w); return r; }
__device__ __forceinline__ float wave_sum(float v, int lane) {
#pragma unroll
    for (int o = 1; o < 64; o <<= 1) v += __builtin_bit_cast(float, __builtin_amdgcn_ds_bpermute((lane ^ o) << 2, __builtin_bit_cast(int, v)));
    return v;
}
__device__ __forceinline__ float silu_f(float x) { return x * pg8::sigmoid_f(x); }

struct Args { const float* in[28]; float* out; unsigned char* ws; };
typedef const __attribute__((address_space(4))) char* kargp_t;
__device__ __forceinline__ kargp_t karg_base() { kargp_t k = (kargp_t)__builtin_amdgcn_kernarg_segment_ptr(); asm volatile("" : "+s"(k)); return k; }
__device__ __forceinline__ const float* inp(int i) { return *(const float* const __attribute__((address_space(4)))*)(karg_base() + 8 * i); }
__device__ __forceinline__ float* outp() { return *(float* const __attribute__((address_space(4)))*)(karg_base() + 8 * 28); }
__device__ __forceinline__ unsigned char* wsp() { return *(unsigned char* const __attribute__((address_space(4)))*)(karg_base() + 8 * 29); }

struct Frame {
    LAS unsigned char* lds;
    int wave0;
    int tid, lane, wave, vcu, G, gw, NGW;
};

__device__ __forceinline__ int lane_id_asm() { int l; asm volatile("v_mbcnt_lo_u32_b32 %0, -1, 0\n\tv_mbcnt_hi_u32_b32 %0, -1, %0" : "=v"(l)); return l; }
__device__ __forceinline__ void relaunder(Frame& F) {
    int w = F.wave0, bx = blockIdx.x, G = gridDim.x; asm volatile("" : "+s"(w), "+s"(bx), "+s"(G));
    F.lane = lane_id_asm(); F.wave = w; F.tid = w * 64 + F.lane;
    F.G = G; F.vcu = (G % 8 == 0) ? (bx % 8) * (G / 8) + bx / 8 : bx;
    F.gw = F.vcu * NWAVES + F.wave; F.NGW = G * NWAVES;
}
__device__ __forceinline__ void transpose_item(const float* W, int ld, int K, bf16* WT, int k0, int n0, int drow0, const float* gk, LAS float* scr, int lane) {
    f32x4 v[8];
#pragma unroll
    for (int i = 0; i < 8; ++i) v[i] = *(const f32x4*)(W + (size_t)(k0 + 8 * i + (lane >> 3)) * ld + n0 + 4 * (lane & 7));
    if (gk) {
#pragma unroll
        for (int i = 0; i < 8; ++i) v[i] = v[i] * gk[k0 + 8 * i + (lane >> 3)]; }
#pragma unroll
    for (int i = 0; i < 8; ++i) { LAS float* s = scr + (8 * i + (lane >> 3)) * 33 + 4 * (lane & 7); s[0] = v[i].x; s[1] = v[i].y; s[2] = v[i].z; s[3] = v[i].w; }
    LDS_WAIT(); asm volatile("" ::: "memory");
    const int c = lane & 7;
#pragma unroll
    for (int j = 0; j < 4; ++j) { const int n = (lane >> 3) + 8 * j; const LAS float* s = scr + (8 * c) * 33 + n;
        u32x4v o; o.x = pk_bf16(s[0 * 33], s[1 * 33]); o.y = pk_bf16(s[2 * 33], s[3 * 33]); o.z = pk_bf16(s[4 * 33], s[5 * 33]); o.w = pk_bf16(s[6 * 33], s[7 * 33]);
        *(u32x4v*)(WT + (size_t)(drow0 + n) * K + k0 + 8 * c) = o; }
    LDS_WAIT(); asm volatile("" ::: "memory");
}
__device__ __forceinline__ void transpose_job(const float* W, int ld, int K, int N, bf16* WT, int mode, int roff, int item, const float* gk, LAS float* scr, int lane) {
    const int nblk = N >> 5, kb = item / nblk, nb = item - kb * nblk, n0 = nb << 5;
    const int drow0 = roff + (mode ? ((n0 >> 7) * 256 + (n0 & 127)) : n0);
    transpose_item(W, ld, K, WT, kb * 64, n0, drow0, gk, scr, lane);
}
__device__ __forceinline__ void phase_prologue(Frame& F) {
    relaunder(F);
    LAS float* scr = (LAS float*)(F.lds + F.wave * 16384);
    constexpr int I_FF = (D / 64) * (FF / 32);
    constexpr int I_A1H = (D / 64) * (D / 32);
    constexpr int I_B1 = (D / 64) * (8192 / 32);
    constexpr int I_B2 = (DSGU / 64) * (D / 32);
    constexpr int N_FFN = 8 * 3 * I_FF, N_A = 2 * 3 * I_A1H, N_B = I_B1 + I_B2, N_C = 4 * I_A1H;
    constexpr int NITEMS = N_FFN + N_A + N_B + N_C;
    unsigned char* ws = wsp();
    for (int it = F.gw; it < NITEMS; it += F.NGW) {
        int r = it;
        if (r < N_FFN) { const int f = r / (3 * I_FF), rr = r - f * 3 * I_FF, which = rr / I_FF, item = rr - which * I_FF;
            const float* gk = ((f & 1) ? inp(6) : inp(4)) + (size_t)(f >> 1) * D;
            if (which == 0)      transpose_job(inp(8) + (size_t)f * D * FF, FF, D, FF, (bf16*)(ws + WS_WGU + f * SZ_WGU), 1, 0, item, gk, scr, F.lane);
            else if (which == 1) transpose_job(inp(9) + (size_t)f * D * FF, FF, D, FF, (bf16*)(ws + WS_WGU + f * SZ_WGU), 1, 128, item, gk, scr, F.lane);
            else                 transpose_job(inp(10) + (size_t)f * FF * D, D, FF, D, (bf16*)(ws + WS_WD + f * SZ_WD), 0, 0, item, nullptr, scr, F.lane);
            continue; }
        r -= N_FFN;
        if (r < N_A) { const int j = r / (3 * I_A1H), rr = r - j * 3 * I_A1H, which = rr / I_A1H, item = rr - which * I_A1H;
            const float* gk = inp(5) + (size_t)(3 * j) * D;
            if (which == 0)      transpose_job(inp(11) + (size_t)j * D * 4096, 4096, D, D, (bf16*)(ws + WS_WA1 + j * SZ_WA1), 1, 0, item, gk, scr, F.lane);
            else if (which == 1) transpose_job(inp(11) + (size_t)j * D * 4096 + 2048, 4096, D, D, (bf16*)(ws + WS_WA1 + j * SZ_WA1), 1, 128, item, gk, scr, F.lane);
            else                 transpose_job(inp(17) + (size_t)j * D * D, D, D, D, (bf16*)(ws + WS_WA2 + j * SZ_WA2), 0, 0, item, nullptr, scr, F.lane);
            continue; }
        r -= N_A;
        if (r < N_B) {
            if (r < I_B1) transpose_job(inp(18), 8192, D, 8192, (bf16*)(ws + WS_WB1), 0, 0, r, inp(5) + (size_t)1 * D, scr, F.lane);
            else          transpose_job(inp(24), D, DSGU, D, (bf16*)(ws + WS_WB2), 0, 0, r - I_B1, nullptr, scr, F.lane);
            continue; }
        r -= N_B;
        { const int which = r / I_A1H, item = r - which * I_A1H;
            const float* gk = inp(5) + (size_t)2 * D;
            if (which == 0)      transpose_job(inp(25), 6144, D, D, (bf16*)(ws + WS_WC1), 0, 4096, item, gk, scr, F.lane);
            else if (which == 1) transpose_job(inp(25) + 2048, 6144, D, D, (bf16*)(ws + WS_WC1), 1, 0, item, gk, scr, F.lane);
            else if (which == 2) transpose_job(inp(25) + 4096, 6144, D, D, (bf16*)(ws + WS_WC1), 1, 128, item, gk, scr, F.lane);
            else                 transpose_job(inp(27), D, D, D, (bf16*)(ws + WS_WC2), 0, 0, item, nullptr, scr, F.lane); }
    }
    { const float* wsrc = inp(22); bf16* wsb = (bf16*)(ws + WS_WSB);
      for (int i = F.gw * 64 + F.lane; i < NG * CHUNK * CHUNK; i += F.NGW * 64) { const int s = i & 127, t = (i >> 7) & 127; const float v = (s <= t) ? wsrc[i] : 0.f; wsb[i] = (bf16)(pk_bf16(v, 0.f) & 0xffffu); } }
}

__device__ __forceinline__ void phase_init(Frame& F) {
    relaunder(F);
    float* X = (float*)(wsp() + WS_X); bf16* XB = (bf16*)(wsp() + WS_XN); float* RS = (float*)(wsp() + WS_RS);
    for (int m = F.gw; m < T; m += F.NGW) {
        const float* src = (m < TPROMPT) ? inp(0) + (size_t)m * D : inp(1) + (size_t)(m - TPROMPT) * D;
        f32x4 v[8]; float s = 0.f;
#pragma unroll
        for (int j = 0; j < 8; ++j) { v[j] = ((const f32x4*)src)[64 * j + F.lane]; s += (v[j].x * v[j].x + v[j].y * v[j].y) + (v[j].z * v[j].z + v[j].w * v[j].w); }
#pragma unroll
        for (int j = 0; j < 8; ++j) { ((f32x4*)(X + (size_t)m * D))[64 * j + F.lane] = v[j]; ((u32x2v*)(XB + (size_t)m * D))[64 * j + F.lane] = f32_to_bf4(v[j]); }
        const float rs = 1.0f / sqrtf(wave_sum(s, F.lane) * (1.0f / D) + EPS);
        if (F.lane == 0) RS[m] = rs;
    }
}
__device__ __forceinline__ void phase_fix(Frame& F, int nsplit, float scale) {
    relaunder(F);
    float* X = (float*)(wsp() + WS_X); bf16* XB = (bf16*)(wsp() + WS_XN); float* RS = (float*)(wsp() + WS_RS); const float* PS = (const float*)(wsp() + WS_PS);
    for (int m = F.vcu * (NWAVES * 64) + F.tid; m < TPROMPT; m += F.G * (NWAVES * 64)) {
        const f32x4* p = (const f32x4*)(PS + (size_t)m * 32); f32x4 a = p[0];
#pragma unroll
        for (int i = 1; i < 8; ++i) a += p[i];
        RS[m] = 1.0f / sqrtf(((a.x + a.y) + (a.z + a.w)) * (1.0f / D) + EPS);
    }
    LAS float* red = (LAS float*)F.lds;
    for (int bq = F.vcu; bq < NSB; bq += F.G) {
        const size_t m = TPROMPT + bq; const int c0 = 4 * F.tid;
        const float* sl = (const float*)(wsp() + WS_SLAB) + (size_t)bq * D + c0;
        f32x4 part[22];
#pragma unroll
        for (int sp = 0; sp < 22; ++sp) { part[sp] = (f32x4){0.f, 0.f, 0.f, 0.f}; if (sp < nsplit) part[sp] = *(const f32x4*)(sl + (size_t)sp * 128 * D); }
        f32x4 x = *(const f32x4*)(X + m * D + c0);
#pragma unroll
        for (int sp = 0; sp < 22; ++sp) x += part[sp] * scale;
        *(f32x4*)(X + m * D + c0) = x; *(u32x2v*)(XB + m * D + c0) = f32_to_bf4(x);
        const float s = wave_sum((x.x * x.x + x.y * x.y) + (x.z * x.z + x.w * x.w), F.lane);
        __syncthreads();
        if (F.lane == 0) red[F.wave] = s;
        __syncthreads();
        if (F.tid == 0) { float t = 0.f;
#pragma unroll
            for (int w = 0; w < NWAVES; ++w) t += red[w];
            RS[m] = 1.0f / sqrtf(t * (1.0f / D) + EPS); }
    }
}
__device__ __forceinline__ void phase_final(Frame& F) {
    relaunder(F);
    const float* X = (const float*)(wsp() + WS_X); const float* g = inp(7);
    f32x4 gv[8];
#pragma unroll
    for (int j = 0; j < 8; ++j) gv[j] = ((const f32x4*)g)[64 * j + F.lane];
    for (int m = F.gw; m < T; m += F.NGW) {
        f32x4 v[8]; float s = 0.f;
#pragma unroll
        for (int j = 0; j < 8; ++j) v[j] = ((const f32x4*)(X + (size_t)m * D))[64 * j + F.lane];
        if (m >= TPROMPT) { const float* sl = (const float*)(wsp() + WS_SLAB) + (size_t)(m - TPROMPT) * D;
#pragma unroll
            for (int j = 0; j < 8; ++j) { f32x4 p[NSPLIT_D];
#pragma unroll
                for (int sp = 0; sp < NSPLIT_D; ++sp) p[sp] = ((const f32x4*)(sl + (size_t)sp * 128 * D))[64 * j + F.lane];
#pragma unroll
                for (int sp = 0; sp < NSPLIT_D; ++sp) v[j] += p[sp] * 0.5f; } }
#pragma unroll
        for (int j = 0; j < 8; ++j) s += (v[j].x * v[j].x + v[j].y * v[j].y) + (v[j].z * v[j].z + v[j].w * v[j].w);
        const float rs = 1.0f / sqrtf(wave_sum(s, F.lane) * (1.0f / D) + EPS);
        f32x4* o = (f32x4*)(outp() + O_YP + (size_t)m * D) + F.lane;
#pragma unroll
        for (int j = 0; j < 8; ++j) o[64 * j] = (v[j] * rs) * gv[j];
    }
}

template <int R> __device__ __forceinline__ void ln_silu_store(Frame& F, f32x4 (&acc)[R], const f32x4 g, const f32x4 b, bf16* y0  , LAS float* red) {
    float s[R];
#pragma unroll
    for (int r = 0; r < R; ++r) s[r] = wave_sum((acc[r].x + acc[r].y) + (acc[r].z + acc[r].w), F.lane);
    if (F.lane == 0) {
#pragma unroll
        for (int r = 0; r < R; ++r) red[F.wave * R + r] = s[r]; }
    __syncthreads();
    float mu[R];
#pragma unroll
    for (int r = 0; r < R; ++r) { float t = 0.f;
#pragma unroll
        for (int w = 0; w < NWAVES; ++w) t += red[w * R + r];
        mu[r] = t * (1.0f / D); }
#pragma unroll
    for (int r = 0; r < R; ++r) { const f32x4 d = acc[r] - mu[r]; s[r] = wave_sum((d.x * d.x + d.y * d.y) + (d.z * d.z + d.w * d.w), F.lane); }
    LAS float* red2 = red + NWAVES * R;
    if (F.lane == 0) {
#pragma unroll
        for (int r = 0; r < R; ++r) red2[F.wave * R + r] = s[r]; }
    __syncthreads();
#pragma unroll
    for (int r = 0; r < R; ++r) { float t = 0.f;
#pragma unroll
        for (int w = 0; w < NWAVES; ++w) t += red2[w * R + r];
        const float rstd = 1.0f / sqrtf(t * (1.0f / D) + EPS);
        f32x4 y = ((acc[r] - mu[r]) * rstd) * g + b;
        y.x = silu_f(y.x); y.y = silu_f(y.y); y.z = silu_f(y.z); y.w = silu_f(y.w);
        *(u32x2v*)(y0 + (size_t)r * D) = f32_to_bf4(y); }
}
__device__ __forceinline__ void phase_convA(Frame& F, int j) {
    relaunder(F);
    const float* wdw = inp(13) + (size_t)j * CAW * D; const float* st = inp(2) + (size_t)j * NSB * 30 * D;
    const bf16* GLU = (const bf16*)(wsp() + WS_ACT); bf16* Y = (bf16*)(wsp() + WS_Y);
    LAS float* red = (LAS float*)F.lds;
    const int c0 = 4 * F.tid;
    const f32x4 bd = *(const f32x4*)(inp(14) + (size_t)j * D + c0), lg = *(const f32x4*)(inp(15) + (size_t)j * D + c0), lb = *(const f32x4*)(inp(16) + (size_t)j * D + c0);
    for (int it = F.vcu; it < TPROMPT / 8; it += F.G) {
        const int bq = it >> 8, t0 = (it & 255) * 8; const size_t m0 = (size_t)bq * SEQ + t0;
        u32x2v x[38];
#pragma unroll
        for (int i = 0; i < 38; ++i) { const int t = t0 - 30 + i; x[i] = (u32x2v){0u, 0u}; if (t >= 0) x[i] = *(const u32x2v*)(GLU + ((size_t)bq * SEQ + t) * D + c0); }
        f32x4 acc[8];
#pragma unroll
        for (int r = 0; r < 8; ++r) acc[r] = bd;
#pragma unroll
        for (int kb = 0; kb < 32; kb += 4) {
            f32x4 wk[4];
#pragma unroll
            for (int kk = 0; kk < 4; ++kk) if (kb + kk < CAW) wk[kk] = *(const f32x4*)(wdw + (size_t)(kb + kk) * D + c0);
            asm volatile("" ::: "memory");
#pragma unroll
            for (int kk = 0; kk < 4; ++kk) if (kb + kk < CAW) {
#pragma unroll
                for (int r = 0; r < 8; ++r) acc[r] += wk[kk] * bf4_to_f32(x[r + kb + kk]); }
        }
        ln_silu_store<8>(F, acc, lg, lb, Y + m0 * D + c0, red);
    }
    for (int it = F.vcu; it < NSB; it += F.G) {
        const size_t m = TPROMPT + it;
        f32x4 acc[1]; acc[0] = bd;
#pragma unroll
        for (int kb = 0; kb < 30; kb += 6) { f32x4 xs[6], wk[6];
#pragma unroll
            for (int kk = 0; kk < 6; ++kk) { xs[kk] = *(const f32x4*)(st + ((size_t)it * 30 + kb + kk) * D + c0); wk[kk] = *(const f32x4*)(wdw + (size_t)(kb + kk) * D + c0); }
            asm volatile("" ::: "memory");
#pragma unroll
            for (int kk = 0; kk < 6; ++kk) acc[0] += wk[kk] * xs[kk]; }
        { const float* sl = (const float*)(wsp() + WS_SLAB) + (size_t)it * 4096 + (c0 >> 7) * 256 + (c0 & 127);
          f32x4 av = (f32x4){0.f, 0.f, 0.f, 0.f}, gt = av; const float rs = ((const float*)(wsp() + WS_RS))[m];
#pragma unroll
          for (int sp = 0; sp < 8; ++sp) { av += *(const f32x4*)(sl + (size_t)sp * 128 * 4096); gt += *(const f32x4*)(sl + (size_t)sp * 128 * 4096 + 128); }
          av = av * rs + *(const f32x4*)(inp(12) + (size_t)j * 4096 + c0); gt = gt * rs + *(const f32x4*)(inp(12) + (size_t)j * 4096 + 2048 + c0);
          f32x4 glu; glu.x = av.x * pg8::sigmoid_f(gt.x); glu.y = av.y * pg8::sigmoid_f(gt.y); glu.z = av.z * pg8::sigmoid_f(gt.z); glu.w = av.w * pg8::sigmoid_f(gt.w);
          *(f32x4*)(outp() + O_AS + ((size_t)(j * NSB + it) * 30 + 29) * D + c0) = glu;
          acc[0] += *(const f32x4*)(wdw + (size_t)30 * D + c0) * glu; }
        ln_silu_store<1>(F, acc, lg, lb, Y + m * D + c0, red);
    }
    for (int idx = F.gw; idx < NB * 30 + NSB * 30; idx += F.NGW) {
        if (idx < NB * 30) { const int bq = idx / 30, i = idx - bq * 30; const bf16* src = GLU + ((size_t)bq * SEQ + SEQ - 30 + i) * D; float* dst = outp() + O_AP + ((size_t)(j * NB + bq) * 30 + i) * D;
#pragma unroll
            for (int q = 0; q < 8; ++q) ((f32x4*)dst)[64 * q + F.lane] = bf4_to_f32(((const u32x2v*)src)[64 * q + F.lane]); }
        else { const int r = idx - NB * 30, bq = r / 30, i = r - bq * 30; float* dst = outp() + O_AS + ((size_t)(j * NSB + bq) * 30 + i) * D;
            if (i < 29) { const float* src = st + ((size_t)bq * 30 + i + 1) * D;
#pragma unroll
                for (int q = 0; q < 8; ++q) ((f32x4*)dst)[64 * q + F.lane] = ((const f32x4*)src)[64 * q + F.lane]; }
        }
    }
}

__device__ __forceinline__ void phase_convC(Frame& F) {
    relaunder(F);
    const bf16* ACT = (const bf16*)(wsp() + WS_ACT); bf16* Y = (bf16*)(wsp() + WS_Y);
    const float* cw = inp(26); const float* st = inp(3);
    f32x4 w0[8], w1[8], w2[8];
#pragma unroll
    for (int q = 0; q < 8; ++q) { w0[q] = ((const f32x4*)cw)[64 * q + F.lane]; w1[q] = ((const f32x4*)(cw + D))[64 * q + F.lane]; w2[q] = ((const f32x4*)(cw + 2 * D))[64 * q + F.lane]; }
    for (int m = F.gw; m < T; m += F.NGW) {
        const bf16* r0 = ACT + (size_t)m * 4096;
#pragma unroll
        for (int q = 0; q < 8; ++q) {
            const int e = 64 * q + F.lane;
            f32x4 cx0, bg, cx1 = (f32x4){0.f, 0.f, 0.f, 0.f}, cx2 = (f32x4){0.f, 0.f, 0.f, 0.f};
            if (m < TPROMPT) { const int t = m & (SEQ - 1);
                cx0 = bf4_to_f32(((const u32x2v*)r0)[e]); bg = bf4_to_f32(((const u32x2v*)(r0 + 2048))[e]);
                if (t >= 1) cx1 = bf4_to_f32(((const u32x2v*)(r0 - 4096))[e]);
                if (t >= 2) cx2 = bf4_to_f32(((const u32x2v*)(r0 - 2 * 4096))[e]); }
            else { const int bq = m - TPROMPT, oc = 4 * e;
                const float* sl = (const float*)(wsp() + WS_SLAB) + (size_t)bq * 6144;
                const int colc = (oc >> 7) * 256 + (oc & 127);
                f32x4 cg = (f32x4){0.f, 0.f, 0.f, 0.f}, xi = cg; bg = cg;
#pragma unroll
                for (int sp = 0; sp < 8; ++sp) { const float* p = sl + (size_t)sp * 128 * 6144; cg += *(const f32x4*)(p + colc); xi += *(const f32x4*)(p + colc + 128); bg += *(const f32x4*)(p + 4096 + oc); }
                { const float rs = ((const float*)(wsp() + WS_RS))[m]; cx0 = (cg * rs) * (xi * rs); bg = bg * rs; }
                cx2 = ((const f32x4*)(st + ((size_t)bq * 2 + 0) * D))[e]; cx1 = ((const f32x4*)(st + ((size_t)bq * 2 + 1) * D))[e];
                ((f32x4*)(outp() + O_CS + ((size_t)bq * 2 + 1) * D))[e] = cx0; }
            const f32x4 y = bg * (w0[q] * cx2 + w1[q] * cx1 + w2[q] * cx0);
            ((u32x2v*)(Y + (size_t)m * D))[e] = f32_to_bf4(y);
        }
    }
    for (int idx = F.gw; idx < NB * 2 + NSB * 2; idx += F.NGW) {
        if (idx < NB * 2) { const int bq = idx >> 1, i = idx & 1; const bf16* src = ACT + ((size_t)bq * SEQ + SEQ - 2 + i) * 4096; float* dst = outp() + O_CP + (size_t)idx * D;
#pragma unroll
            for (int q = 0; q < 8; ++q) ((f32x4*)dst)[64 * q + F.lane] = bf4_to_f32(((const u32x2v*)src)[64 * q + F.lane]); }
        else { const int r = idx - NB * 2, bq = r >> 1, i = r & 1; float* dst = outp() + O_CS + (size_t)r * D;
            if (i == 0) { const float* src = st + ((size_t)bq * 2 + 1) * D;
#pragma unroll
                for (int q = 0; q < 8; ++q) ((f32x4*)dst)[64 * q + F.lane] = ((const f32x4*)src)[64 * q + F.lane]; }
        }
    }
}

__device__ __forceinline__ void phase_sguLN(Frame& F) {
    relaunder(F);
    bf16* Z = (bf16*)(wsp() + WS_ACT); const float* lg = inp(20); const float* lb = inp(21);
    for (int m = F.gw; m < T; m += F.NGW) {
        bf16* vr = Z + (size_t)m * 8192 + DSGU;
        f32x4 v[16]; float s = 0.f;
        if (m < TPROMPT) {
#pragma unroll
            for (int q = 0; q < 8; ++q) { const u32x4v raw = ((const u32x4v*)vr)[64 * q + F.lane];
                v[2 * q] = bf4_to_f32((u32x2v){raw.x, raw.y}); v[2 * q + 1] = bf4_to_f32((u32x2v){raw.z, raw.w}); }
        } else {
            const float* sl = (const float*)(wsp() + WS_SLAB) + (size_t)(m - TPROMPT) * 8192; const float* bias = inp(19); const float rs_s = ((const float*)(wsp() + WS_RS))[m];
#pragma unroll
            for (int half = 0; half < 2; ++half)
#pragma unroll
                for (int q = 0; q < 8; ++q) { const int col = half * DSGU + (64 * q + F.lane) * 8;
                    f32x4 a = (f32x4){0.f, 0.f, 0.f, 0.f}, b = a;
#pragma unroll
                    for (int sp = 0; sp < 8; ++sp) { a += *(const f32x4*)(sl + (size_t)sp * 128 * 8192 + col); b += *(const f32x4*)(sl + (size_t)sp * 128 * 8192 + col + 4); }
                    a = a * rs_s + *(const f32x4*)(bias + col); b = b * rs_s + *(const f32x4*)(bias + col + 4);
                    const pg8::f32x2 g0 = pg8::gelu_pk((pg8::f32x2){a.x, a.y}), g1 = pg8::gelu_pk((pg8::f32x2){a.z, a.w}), g2 = pg8::gelu_pk((pg8::f32x2){b.x, b.y}), g3 = pg8::gelu_pk((pg8::f32x2){b.z, b.w});
                    a = (f32x4){g0.x, g0.y, g1.x, g1.y}; b = (f32x4){g2.x, g2.y, g3.x, g3.y};
                    if (half == 0) { const u32x2v pa = f32_to_bf4(a), pb = f32_to_bf4(b); *(u32x4v*)(Z + (size_t)m * 8192 + col) = (u32x4v){pa.x, pa.y, pb.x, pb.y}; }
                    else { v[2 * q] = a; v[2 * q + 1] = b; } }
        }
#pragma unroll
        for (int q = 0; q < 16; ++q) s += (v[q].x + v[q].y) + (v[q].z + v[q].w);
        const float mu = wave_sum(s, F.lane) * (1.0f / DSGU); float s2 = 0.f;
#pragma unroll
        for (int q = 0; q < 16; ++q) { v[q] = v[q] - mu; s2 += (v[q].x * v[q].x + v[q].y * v[q].y) + (v[q].z * v[q].z + v[q].w * v[q].w); }
        const float rstd = 1.0f / sqrtf(wave_sum(s2, F.lane) * (1.0f / DSGU) + EPS);
        float* fo = nullptr;
        if (m >= TPROMPT) fo = outp() + O_VS + (size_t)(m - TPROMPT) * DSGU;
        else { const int t = m & (SEQ - 1); if (t >= SEQ - CHUNK) fo = outp() + O_VP + ((size_t)(m >> 11) * CHUNK + (t - (SEQ - CHUNK))) * DSGU; }
#pragma unroll
        for (int q = 0; q < 8; ++q) { const int e = (64 * q + F.lane) * 2;
            const f32x4 a = (v[2 * q] * rstd) * ((const f32x4*)lg)[e] + ((const f32x4*)lb)[e];
            const f32x4 b = (v[2 * q + 1] * rstd) * ((const f32x4*)lg)[e + 1] + ((const f32x4*)lb)[e + 1];
            const u32x2v pa = f32_to_bf4(a), pb = f32_to_bf4(b);
            ((u32x4v*)vr)[64 * q + F.lane] = (u32x4v){pa.x, pa.y, pb.x, pb.y};
            if (fo) { ((f32x4*)fo)[e] = a; ((f32x4*)fo)[e + 1] = b; } }
    }
}
__device__ __forceinline__ void phase_sguMix(Frame& F) {
    relaunder(F);
    const bf16* Z = (const bf16*)(wsp() + WS_ACT); bf16* Y = (bf16*)(wsp() + WS_Y); const bf16* WSB = (const bf16*)(wsp() + WS_WSB); const float* bs = inp(23);
    constexpr int VST = 544;
    const int l15 = F.lane & 15, g4 = F.lane >> 4;
    for (int it = F.vcu; it < 64 * NG * 2; it += F.G) {
        const int q = it >> 4, g = (it >> 1) & 7, h = it & 1; const size_t m0 = (size_t)q * CHUNK; const int colv = g * DG + h * 256;
        __syncthreads();
#pragma unroll
        for (int i = 0; i < 8; ++i) { const int idx = F.tid + 512 * i, s = idx >> 5, ch = idx & 31;
            const u32x4v raw = *(const u32x4v*)(Z + (m0 + s) * 8192 + DSGU + colv + ch * 8);
            *(LAS u32x4v*)(F.lds + s * VST + ch * 16) = raw; }
        __syncthreads();
#pragma unroll
        for (int job = 0; job < 2; ++job) {
            const int tb = job ? 7 - F.wave : F.wave, dbase = job * 8, nks = (tb + 2) >> 1;
            f32x4 acc[8];
#pragma unroll
            for (int dt = 0; dt < 8; ++dt) acc[dt] = (f32x4){0.f, 0.f, 0.f, 0.f};
            for (int ks = 0; ks < nks; ++ks) {
                const bf16* wrow = WSB + ((size_t)g * CHUNK + 16 * tb + l15) * CHUNK + 32 * ks + 4 * g4;
                const u32x2v wlo = *(const u32x2v*)wrow, whi = *(const u32x2v*)(wrow + 16);
                const bf16x8 wf = __builtin_bit_cast(bf16x8, (u32x4v){wlo.x, wlo.y, whi.x, whi.y});
                LAS unsigned char* vb = F.lds + (32 * ks + 4 * g4 + (l15 >> 2)) * VST + (16 * dbase + 4 * (l15 & 3)) * 2;
#pragma unroll
                for (int dt = 0; dt < 8; ++dt) {
                    const s16x4 lo = __builtin_bit_cast(s16x4, __builtin_amdgcn_ds_read_tr16_b64_v4i16((LAS s16x4*)(vb + dt * 32)));
                    const s16x4 hi = __builtin_bit_cast(s16x4, __builtin_amdgcn_ds_read_tr16_b64_v4i16((LAS s16x4*)(vb + dt * 32 + 16 * VST)));
                    const bf16x8 vf = (bf16x8){lo[0], lo[1], lo[2], lo[3], hi[0], hi[1], hi[2], hi[3]};
                    acc[dt] = __builtin_amdgcn_mfma_f32_16x16x32_bf16(vf, wf, acc[dt], 0, 0, 0);
                }
            }
            const int t = 16 * tb + l15; const float bias = bs[g * CHUNK + t];
#pragma unroll
            for (int dt = 0; dt < 8; ++dt) { const int col = colv + 16 * (dbase + dt) + 4 * g4;
                const f32x4 u = bf4_to_f32(*(const u32x2v*)(Z + (m0 + t) * 8192 + col));
                *(u32x2v*)(Y + (m0 + t) * DSGU + col) = f32_to_bf4(u * (acc[dt] + bias)); }
        }
    }
    const float* wsf = inp(22);
    for (int bq = F.gw; bq < NSB; bq += F.NGW) { const size_t m = TPROMPT + bq;
#pragma unroll
        for (int qq = 0; qq < 8; ++qq) { const int c = (64 * qq + F.lane) * 8, g = c >> 9; const float w00 = wsf[(size_t)g * CHUNK * CHUNK], b0 = bs[g * CHUNK];
            const u32x4v ur = *(const u32x4v*)(Z + m * 8192 + c), vr = *(const u32x4v*)(Z + m * 8192 + DSGU + c);
            const f32x4 ua = bf4_to_f32((u32x2v){ur.x, ur.y}), ub = bf4_to_f32((u32x2v){ur.z, ur.w}), va = bf4_to_f32((u32x2v){vr.x, vr.y}), vb2 = bf4_to_f32((u32x2v){vr.z, vr.w});
            const u32x2v pa = f32_to_bf4(ua * (va * w00 + b0)), pb = f32_to_bf4(ub * (vb2 * w00 + b0));
            *(u32x4v*)(Y + m * DSGU + c) = (u32x4v){pa.x, pa.y, pb.x, pb.y}; } }
}

template <class Epi> __device__ __forceinline__ void run_gemm(Frame& F, const bf16* A, const bf16* Bt, int N, int K, int nsplit, const Epi& E) {
    LAS unsigned char* lds = F.lds; relaunder(F);
    int bx = blockIdx.x, G = gridDim.x; asm volatile("" : "+s"(bx), "+s"(G));
    pg8::Gemm g{A, Bt, TP, N, K}; pg8::MixOrder S; S.init(TPROMPT, N, K, G, bx, TPROMPT / 256, nsplit);
    pg8::EpiSlab<Epi> ES{E, (float*)(wsp() + WS_SLAB), N};
    pg8::gemm_phase<pg8::EpiSlab<Epi>, pg8::MixOrder, true, true>(lds, g, S, ES, F.tid);
}
__global__ void __launch_bounds__(NWAVES * 64, 2) mk_fwd(Args args) {
    extern __shared__ __attribute__((aligned(16))) unsigned char lds_raw[];
    Frame F;
    F.lds = (LAS unsigned char*)lds_raw;
    { int w = __builtin_amdgcn_readfirstlane((int)threadIdx.x >> 6); asm volatile("" : "+s"(w)); F.wave0 = w; }
    relaunder(F);
    for (int u = F.tid; u < (LDS_BYTES - LDSCTL_OFF) / 4; u += NWAVES * 64) ((LAS unsigned*)(F.lds + LDSCTL_OFF))[u] = 0u;
    __syncthreads();
    (void)xcd_barrier_post((unsigned*)(wsp() + WS_CTL) + CW_BAR, (volatile LAS unsigned*)(F.lds + MISC_OFF) + 8, F.tid);
#define GRID_BAR() do { relaunder(F); XcdBarrier b_; b_.bar = (unsigned*)(wsp() + WS_CTL) + CW_BAR; b_.x = xb_xcc_id(); b_.st = (volatile LAS unsigned*)(F.lds + MISC_OFF) + 8; xcd_barrier(b_, F.tid); } while (0)
#define P_X   ((float*)(wsp() + WS_X))
#define P_XN  ((bf16*)(wsp() + WS_XN))
#define P_ACT ((bf16*)(wsp() + WS_ACT))
#define P_Y   ((bf16*)(wsp() + WS_Y))

    phase_prologue(F); phase_init(F); GRID_BAR();
#define P_RS  ((const float*)(wsp() + WS_RS))
#define P_PS  ((float*)(wsp() + WS_PS))
    for (int L = 0; L < DEPTH; ++L) {
        const int kind = L % 3, j = L / 3, nsp_out = (kind == 1) ? 16 : 8;
        for (int f = 0; f < 2; ++f) {
            { pg8::EpiPair<0> E{P_ACT, FF, nullptr, P_RS};
              run_gemm(F, P_XN, (const bf16*)(wsp() + WS_WGU + (size_t)(L * 2 + f) * SZ_WGU), 2 * FF, D, 1, E); }
            GRID_BAR();
            { pg8::EpiResid E{P_X, P_XN, P_PS, D, 0.5f};
              run_gemm(F, P_ACT, (const bf16*)(wsp() + WS_WD + (size_t)(L * 2 + f) * SZ_WD), D, FF, NSPLIT_D, E); }
            GRID_BAR();
            if (f == 0) {
                phase_fix(F, NSPLIT_D, 0.5f); GRID_BAR();
                const bf16* wout; int kout;
                if (kind == 0) {
                    { pg8::EpiPair<1> E{P_ACT, D, inp(12) + (size_t)j * 4096, P_RS};
                      run_gemm(F, P_XN, (const bf16*)(wsp() + WS_WA1 + (size_t)j * SZ_WA1), 4096, D, 8, E); }
                    GRID_BAR();
                    phase_convA(F, j); GRID_BAR();
                    wout = (const bf16*)(wsp() + WS_WA2 + (size_t)j * SZ_WA2); kout = D;
                } else if (kind == 1) {
                    { pg8::EpiGelu E{P_ACT, 8192, inp(19), P_RS};
                      run_gemm(F, P_XN, (const bf16*)(wsp() + WS_WB1), 8192, D, 8, E); }
                    GRID_BAR();
                    phase_sguLN(F); GRID_BAR();
                    phase_sguMix(F); GRID_BAR();
                    wout = (const bf16*)(wsp() + WS_WB2); kout = DSGU;
                } else {
                    { pg8::EpiPair<2> E{P_ACT, 4096, nullptr, P_RS};
                      run_gemm(F, P_XN, (const bf16*)(wsp() + WS_WC1), 6144, D, 8, E); }
                    GRID_BAR();
                    phase_convC(F); GRID_BAR();
                    wout = (const bf16*)(wsp() + WS_WC2); kout = D;
                }
                { pg8::EpiResid E{P_X, P_XN, P_PS, D, 1.0f};
                  run_gemm(F, P_Y, wout, D, kout, nsp_out, E); }
                GRID_BAR();
                phase_fix(F, nsp_out, 1.0f); GRID_BAR();
            } else if (L < DEPTH - 1) { phase_fix(F, NSPLIT_D, 0.5f); GRID_BAR(); }
        }
    }
    phase_final(F);
}

extern "C" void kernel_launch(void* const* d_in, const int* in_sizes, int n_in, void* d_out, int out_size, void* d_ws, size_t ws_size, hipStream_t stream) {
    static int grid = 0;
    if (grid == 0) {
        if (n_in != 28 || (size_t)out_size != O_END || ws_size < WS_END) { fprintf(stderr, "kernel_launch: unexpected shapes (n_in %d, out %d, ws %zu)\n", n_in, out_size, ws_size); grid = -1; return; }
        int dev = 0, cus = 0, per_cu = 0;
        if (hipGetDevice(&dev) != hipSuccess || hipDeviceGetAttribute(&cus, hipDeviceAttributeMultiprocessorCount, dev) != hipSuccess) { grid = -1; return; }
        if (hipFuncSetAttribute((const void*)mk_fwd, hipFuncAttributeMaxDynamicSharedMemorySize, LDS_BYTES) != hipSuccess) { fprintf(stderr, "kernel_launch: hipFuncSetAttribute failed\n"); grid = -1; return; }
        if (hipOccupancyMaxActiveBlocksPerMultiprocessor(&per_cu, (const void*)mk_fwd, NWAVES * 64, LDS_BYTES) != hipSuccess || per_cu < 1) { fprintf(stderr, "kernel_launch: occupancy query says %d\n", per_cu); }
        (void)hipGetLastError();
        grid = cus;
    }
    if (grid < 0) return;
    (void)hipMemsetAsync((char*)d_ws + WS_CTL, 0, CTL_ZERO_BYTES, stream);
    Args a{};
    for (int i = 0; i < 28; ++i) a.in[i] = (const float*)d_in[i];
    a.out = (float*)d_out; a.ws = (unsigned char*)d_ws;
    hipLaunchKernelGGL(mk_fwd, dim3(grid), dim3(NWAVES * 64), LDS_BYTES, stream, a);
}
```

```cpp
#include <hip/hip_runtime.h>
#include <cstdio>
#include <cstdint>
#define GAS __attribute__((address_space(1)))
#define LAS __attribute__((address_space(3)))
namespace pg8 {
#define PG8_LAS __attribute__((address_space(3)))
typedef unsigned short bf16_t;
typedef short bf16x8 __attribute__((ext_vector_type(8)));
typedef float f32x4 __attribute__((ext_vector_type(4)));
typedef unsigned u32x4 __attribute__((ext_vector_type(4)));
constexpr int BM = 256, BK = 64, HALF = 128, HTB = HALF * BK * 2  , STAGE_BYTES = 8 * HTB, NXCD = 8, WGM = 8;

__host__ __device__ __forceinline__ int lds_byte(int r, int c) { const int st = (r >> 4) * 2 + (c >> 5), rr = r & 15, cc = c & 31, ob = rr * 64 + cc * 2; return st * 1024 + (ob ^ (((ob >> 9) & 1) << 5)); }
__host__ __device__ __forceinline__ void stage_rc(int b, int& R, int& C) { const int st = b / 1024, sb = b % 1024, swz = sb ^ (((sb >> 9) & 1) << 5); R = (st >> 1) * 16 + swz / 64; C = (st & 1) * 32 + (swz % 64) / 2; }
__host__ __device__ __forceinline__ int perm32(int rho) { const int n = rho >> 4, i = rho & 15; return 8 * (i >> 2) + 4 * n + (i & 3); }

struct Unit { int pm, pn, kt0, nkt, split; };
struct Gemm { const bf16_t* A; const bf16_t* Bt; int M, N, K; };

struct StaticOrder {
    int nM, nN, nwg, G, c, nkt;
    __host__ __device__ void init(int M, int N, int K, int G_, int c_) { nM = M / BM; nN = N / BM; nwg = nM * nN; G = G_; c = c_; nkt = K / BK; }
    __host__ __device__ bool next(int i, Unit& u) const {
        const long L = (long)i * G + c; if (L >= nwg) return false;
        int wgid = (int)L; { const int q = nwg / NXCD, r = nwg % NXCD, xcd = wgid % NXCD, off = wgid / NXCD; wgid = (xcd < r ? xcd * (q + 1) : r * (q + 1) + (xcd - r) * q) + off; }
        const int nig = WGM * nN, gid = wgid / nig, fm = gid * WGM, gsz = (nM - fm) < WGM ? (nM - fm) : WGM;
        u.pm = fm + ((wgid % nig) % gsz); u.pn = (wgid % nig) / gsz; u.kt0 = 0; u.nkt = nkt; u.split = -1; return true;
    }
    __device__ __forceinline__ void a_ready(const Unit&) const {}
    __device__ __forceinline__ void done(const Unit&) const {}
};
struct MixOrder {
    StaticOrder so; int spm, snN, nsplit, skt, scount, c0, rp;
    __device__ void init(int Mp, int N, int K, int G_, int c_, int spm_, int nsplit_) {
        so.init(Mp, N, K, G_, c_); spm = spm_; snN = N / BM; nsplit = nsplit_; skt = (K / BK) / nsplit_; scount = snN * nsplit_;
        c0 = so.nwg % G_; rp = (so.nwg - c_ + G_ - 1) / G_; if (rp < 0) rp = 0; }
    __device__ bool next(int i, Unit& u) const {
        if (i < rp) return so.next(i, u);
        const int sidx = ((so.c - c0 + so.G) % so.G) + (i - rp) * so.G; if (sidx >= scount) return false;
        const int sp = sidx / snN; u.pm = spm; u.pn = sidx - sp * snN; u.kt0 = sp * skt; u.nkt = skt; u.split = (nsplit > 1) ? sp : -1; return true; }
    __device__ __forceinline__ void a_ready(const Unit&) const {}
    __device__ __forceinline__ void done(const Unit&) const {}
};
__device__ __forceinline__ unsigned cvt_pk_bf16(float lo, float hi) { unsigned r; asm volatile("v_cvt_pk_bf16_f32 %0, %1, %2" : "=v"(r) : "v"(lo), "v"(hi)); return r; }
typedef float f32x2 __attribute__((ext_vector_type(2)));
__device__ __forceinline__ f32x2 gelu_pk(f32x2 v) {
    const f32x2 av = __builtin_elementwise_abs(v), d = av * 0.2316418882f + 1.0f;
    f32x2 t; t.x = __builtin_amdgcn_rcpf(d.x); t.y = __builtin_amdgcn_rcpf(d.y);
    f32x2 q = t * 0.5307027145f + (-0.7265760135f); q = q * t + 0.7107068705f; q = q * t + (-0.142248368f); q = q * t + 0.127414796f; q = q * t;
    const f32x2 s = (v * v) * (-0.72134752044f);
    f32x2 e; e.x = __builtin_amdgcn_exp2f(s.x); e.y = __builtin_amdgcn_exp2f(s.y);
    const f32x2 m = v * (q * e), r = v - m;
    f32x2 o; o.x = v.x < 0.f ? m.x : r.x; o.y = v.y < 0.f ? m.y : r.y; return o;
}

template <int ACT  > struct EpiBf16 {
    static constexpr bool PERM = true, AFTER_DRAIN = false; static_assert(ACT == 0 || ACT == 1, "EpiBf16: ACT is 0 (none) or 1 (gelu_pk)");
    bf16_t* O; int ldc; const float* bias; int split_cols; size_t split_stride; float scale0;
    __device__ __forceinline__ void operator()(const f32x4 (&acc)[2][2][4][2], const Unit& u, int wr, int wc, int fr, int fq) const {
        const int row0 = u.pm * BM + wr * 64 + fr; int colt = u.pn * BM; bf16_t* base = O;
        float sc = 1.f; if (split_cols) { const int t = colt / split_cols; base += (size_t)t * split_stride; colt -= t * split_cols; if (t == 0) sc = scale0; }
        const int col0 = colt + wc * 32 + 8 * fq, bcol0 = u.pn * BM + wc * 32 + 8 * fq;
        f32x4 bv[2][2];
#pragma unroll
        for (int bj = 0; bj < 2; ++bj)
#pragma unroll
            for (int n = 0; n < 2; ++n) bv[bj][n] = bias ? *(const f32x4*)(bias + bcol0 + bj * HALF + 4 * n) : (f32x4){0.f, 0.f, 0.f, 0.f};
#pragma unroll
        for (int ai = 0; ai < 2; ++ai)
#pragma unroll
            for (int m = 0; m < 4; ++m) { bf16_t* rowp = base + (size_t)(row0 + ai * HALF + m * 16) * ldc + col0;
#pragma unroll
                for (int bj = 0; bj < 2; ++bj) { f32x4 v0 = acc[ai][bj][m][0] + bv[bj][0], v1 = acc[ai][bj][m][1] + bv[bj][1];
                    if (ACT == 1) { f32x2 a = gelu_pk((f32x2){v0[0], v0[1]}), b = gelu_pk((f32x2){v0[2], v0[3]}), c = gelu_pk((f32x2){v1[0], v1[1]}), d = gelu_pk((f32x2){v1[2], v1[3]});
                        v0 = (f32x4){a.x, a.y, b.x, b.y}; v1 = (f32x4){c.x, c.y, d.x, d.y}; }
                    v0 = v0 * sc; v1 = v1 * sc; u32x4 w; w.x = cvt_pk_bf16(v0[0], v0[1]); w.y = cvt_pk_bf16(v0[2], v0[3]); w.z = cvt_pk_bf16(v1[0], v1[1]); w.w = cvt_pk_bf16(v1[2], v1[3]);
                    *(u32x4*)(rowp + bj * HALF) = w; } }
    }
};
typedef __amdgpu_buffer_rsrc_t rsrc_t;
__device__ __forceinline__ rsrc_t mk_rsrc(const void* p) { return __builtin_amdgcn_make_buffer_rsrc((void*)p, 0, 0x7ffffff0, 0x00020000); }
__device__ __forceinline__ void st16_wt(rsrc_t r, unsigned byte_off, u32x4 v) { __builtin_amdgcn_raw_buffer_store_b128(v, r, (int)byte_off, 0, 0); }
__device__ __forceinline__ void st16_wt(rsrc_t r, unsigned byte_off, f32x4 v) { __builtin_amdgcn_raw_buffer_store_b128(__builtin_bit_cast(u32x4, v), r, (int)byte_off, 0, 0); }
__device__ __forceinline__ float sigmoid_f(float x) { return __builtin_amdgcn_rcpf(1.0f + __builtin_amdgcn_exp2f(-1.44269504f * x)); }
template <int MODE> struct EpiPair {
    static constexpr bool PERM = true, AFTER_DRAIN = false;
    bf16_t* O; int ldc; const float* bias; const float* RS;
    __device__ __forceinline__ void operator()(const f32x4 (&acc)[2][2][4][2], const Unit& u, int wr, int wc, int fr, int fq) const {
        const int row0 = u.pm * BM + wr * 64 + fr; const rsrc_t orsrc = mk_rsrc(O);
        float rs[2][4];
#pragma unroll
        for (int ai = 0; ai < 2; ++ai)
#pragma unroll
            for (int m = 0; m < 4; ++m) rs[ai][m] = RS[row0 + ai * HALF + m * 16];
        if (MODE == 2 && u.pn >= 16) {
            const int col0 = 2048 + (u.pn - 16) * BM + wc * 32 + 8 * fq;
#pragma unroll
            for (int ai = 0; ai < 2; ++ai)
#pragma unroll
                for (int m = 0; m < 4; ++m) { const int row = row0 + ai * HALF + m * 16; const unsigned ob = (unsigned)(row * ldc + col0) * 2u;
#pragma unroll
                    for (int bj = 0; bj < 2; ++bj) { const f32x4 v0 = acc[ai][bj][m][0] * rs[ai][m], v1 = acc[ai][bj][m][1] * rs[ai][m];
                        u32x4 w; w.x = cvt_pk_bf16(v0[0], v0[1]); w.y = cvt_pk_bf16(v0[2], v0[3]); w.z = cvt_pk_bf16(v1[0], v1[1]); w.w = cvt_pk_bf16(v1[2], v1[3]);
                        st16_wt(orsrc, ob + bj * HALF * 2, w); } }
            return;
        }
        const int oc0 = u.pn * HALF + wc * 32 + 8 * fq;
        f32x4 b0[2], b1[2];
#pragma unroll
        for (int n = 0; n < 2; ++n) { b0[n] = (MODE == 1) ? *(const f32x4*)(bias + oc0 + 4 * n) : (f32x4){0.f, 0.f, 0.f, 0.f}; b1[n] = (MODE == 1) ? *(const f32x4*)(bias + 2048 + oc0 + 4 * n) : (f32x4){0.f, 0.f, 0.f, 0.f}; }
#pragma unroll
        for (int ai = 0; ai < 2; ++ai)
#pragma unroll
            for (int m = 0; m < 4; ++m) { const int row = row0 + ai * HALF + m * 16; const unsigned ob = (unsigned)(row * ldc + oc0) * 2u;
                f32x4 r[2];
#pragma unroll
                for (int n = 0; n < 2; ++n) { f32x4 f = acc[ai][0][m][n] * rs[ai][m], s = acc[ai][1][m][n] * rs[ai][m];
                    if (MODE == 1) { f += b0[n]; s += b1[n]; }
                    if (MODE == 2) r[n] = f * s;
                    else { const f32x4 x = (MODE == 0) ? f : s;
                        f32x4 ex = x * (-1.44269504f);
                        ex[0] = __builtin_amdgcn_exp2f(ex[0]); ex[1] = __builtin_amdgcn_exp2f(ex[1]); ex[2] = __builtin_amdgcn_exp2f(ex[2]); ex[3] = __builtin_amdgcn_exp2f(ex[3]);
                        ex = ex + 1.0f;
                        f32x4 sg; sg[0] = __builtin_amdgcn_rcpf(ex[0]); sg[1] = __builtin_amdgcn_rcpf(ex[1]); sg[2] = __builtin_amdgcn_rcpf(ex[2]); sg[3] = __builtin_amdgcn_rcpf(ex[3]);
                        r[n] = (MODE == 0) ? (f * s) * sg : f * sg; } }
                u32x4 w; w.x = cvt_pk_bf16(r[0][0], r[0][1]); w.y = cvt_pk_bf16(r[0][2], r[0][3]); w.z = cvt_pk_bf16(r[1][0], r[1][1]); w.w = cvt_pk_bf16(r[1][2], r[1][3]);
                st16_wt(orsrc, ob, w); }
    }
};
struct EpiGelu {
    static constexpr bool PERM = true, AFTER_DRAIN = false;
    bf16_t* O; int ldc; const float* bias; const float* RS;
    __device__ __forceinline__ void operator()(const f32x4 (&acc)[2][2][4][2], const Unit& u, int wr, int wc, int fr, int fq) const {
        const int row0 = u.pm * BM + wr * 64 + fr, col0 = u.pn * BM + wc * 32 + 8 * fq; const rsrc_t orsrc = mk_rsrc(O);
        float rs[2][4];
#pragma unroll
        for (int ai = 0; ai < 2; ++ai)
#pragma unroll
            for (int m = 0; m < 4; ++m) rs[ai][m] = RS[row0 + ai * HALF + m * 16];
        f32x4 bv[2][2];
#pragma unroll
        for (int bj = 0; bj < 2; ++bj)
#pragma unroll
            for (int n = 0; n < 2; ++n) bv[bj][n] = *(const f32x4*)(bias + col0 + bj * HALF + 4 * n);
#pragma unroll
        for (int ai = 0; ai < 2; ++ai)
#pragma unroll
            for (int m = 0; m < 4; ++m) { const int row = row0 + ai * HALF + m * 16; const unsigned ob = (unsigned)(row * ldc + col0) * 2u;
#pragma unroll
                for (int bj = 0; bj < 2; ++bj) { f32x4 v0 = acc[ai][bj][m][0] * rs[ai][m] + bv[bj][0], v1 = acc[ai][bj][m][1] * rs[ai][m] + bv[bj][1];
                    const f32x2 a = gelu_pk((f32x2){v0[0], v0[1]}), b = gelu_pk((f32x2){v0[2], v0[3]}), c = gelu_pk((f32x2){v1[0], v1[1]}), d = gelu_pk((f32x2){v1[2], v1[3]});
                    u32x4 w; w.x = cvt_pk_bf16(a.x, a.y); w.y = cvt_pk_bf16(b.x, b.y); w.z = cvt_pk_bf16(c.x, c.y); w.w = cvt_pk_bf16(d.x, d.y);
                    st16_wt(orsrc, ob + bj * HALF * 2, w); } }
    }
};
struct EpiResid {
    static constexpr bool PERM = true, AFTER_DRAIN = false;
    float* X; bf16_t* XB; float* PS; int ldc; float scale;
    __device__ __forceinline__ void operator()(const f32x4 (&acc)[2][2][4][2], const Unit& u, int wr, int wc, int fr, int fq) const {
        const int row0 = u.pm * BM + wr * 64 + fr, col0 = u.pn * BM + wc * 32 + 8 * fq, lane = fq * 16 + fr; const rsrc_t xr = mk_rsrc(X), br = mk_rsrc(XB);
        f32x4 nx[2][2];
#pragma unroll
        for (int bj = 0; bj < 2; ++bj)
#pragma unroll
            for (int n = 0; n < 2; ++n) nx[bj][n] = *(const f32x4*)(X + (size_t)row0 * ldc + col0 + bj * HALF + n * 4);
#pragma unroll
        for (int g = 0; g < 8; ++g) { const int ai = g >> 2, m = g & 3, row = row0 + ai * HALF + m * 16; const unsigned eo = (unsigned)(row * ldc + col0);
            f32x4 v[2][2];
#pragma unroll
            for (int bj = 0; bj < 2; ++bj)
#pragma unroll
                for (int n = 0; n < 2; ++n) v[bj][n] = nx[bj][n];
            if (g < 7) { const int g1 = g + 1, row1 = row0 + (g1 >> 2) * HALF + (g1 & 3) * 16;
#pragma unroll
                for (int bj = 0; bj < 2; ++bj)
#pragma unroll
                    for (int n = 0; n < 2; ++n) nx[bj][n] = *(const f32x4*)(X + (size_t)row1 * ldc + col0 + bj * HALF + n * 4); }
            float ss = 0.f;
#pragma unroll
            for (int bj = 0; bj < 2; ++bj) {
#pragma unroll
                for (int n = 0; n < 2; ++n) { v[bj][n] += acc[ai][bj][m][n] * scale; st16_wt(xr, (eo + bj * HALF + n * 4) * 4u, v[bj][n]);
                    ss += (v[bj][n][0] * v[bj][n][0] + v[bj][n][1] * v[bj][n][1]) + (v[bj][n][2] * v[bj][n][2] + v[bj][n][3] * v[bj][n][3]); }
                u32x4 w; w.x = cvt_pk_bf16(v[bj][0][0], v[bj][0][1]); w.y = cvt_pk_bf16(v[bj][0][2], v[bj][0][3]); w.z = cvt_pk_bf16(v[bj][1][0], v[bj][1][1]); w.w = cvt_pk_bf16(v[bj][1][2], v[bj][1][3]);
                st16_wt(br, (eo + bj * HALF) * 2u, w); }
            ss += __builtin_bit_cast(float, __builtin_amdgcn_ds_bpermute((lane ^ 16) << 2, __builtin_bit_cast(int, ss)));
            ss += __builtin_bit_cast(float, __builtin_amdgcn_ds_bpermute((lane ^ 32) << 2, __builtin_bit_cast(int, ss)));
            if (fq == 0) PS[(size_t)row * 32 + u.pn * 4 + wc] = ss; }
    }
};
template <class Base> struct EpiSlab {
    static constexpr bool PERM = Base::PERM, AFTER_DRAIN = false;
    Base base; float* slab; int N;
    __device__ __forceinline__ void operator()(const f32x4 (&acc)[2][2][4][2], const Unit& u, int wr, int wc, int fr, int fq) const {
        if (u.split < 0) { base(acc, u, wr, wc, fr, fq); return; }
        const int col0 = u.pn * BM + wc * 32 + (PERM ? 8 * fq : 4 * fq);
        const rsrc_t sr = mk_rsrc(slab); const unsigned e0 = (unsigned)((u.split * 128 + wr * 64 + fr) * N + col0);
#pragma unroll
        for (int m = 0; m < 4; ++m) {
#pragma unroll
            for (int bj = 0; bj < 2; ++bj)
#pragma unroll
                for (int n = 0; n < 2; ++n) st16_wt(sr, (e0 + (unsigned)(m * 16 * N) + bj * HALF + (PERM ? 4 * n : 16 * n)) * 4u, acc[0][bj][m][n]); }
    }
};
template <class Epi, class Sched, bool ALIGN_EPI = false, bool SP2 = false>
__device__ __forceinline__ void gemm_phase(PG8_LAS unsigned char* lds, const Gemm g, const Sched& S, const Epi& E, int tid_in) {
    int tid_ = tid_in; asm volatile("" : "+v"(tid_));
    const int tid = tid_, wid = __builtin_amdgcn_readfirstlane(tid >> 6), lane = tid & 63, wr = wid >> 2, wc = wid & 3, fr = lane & 15, fq = lane >> 4;
    const int K = g.K;
    unsigned voffA[2], voffB[2];
#pragma unroll
    for (int i = 0; i < 2; ++i) { int R, C; stage_rc(tid * 16 + i * 8192, R, C); const int Rb = Epi::PERM ? ((R & ~31) + perm32(R & 31)) : R;
        voffA[i] = (unsigned)(R * K + C) * 2u; voffB[i] = (unsigned)(Rb * K + C) * 2u; }
    const size_t kstep = (size_t)(BK * 2);
    const size_t hstep = (size_t)HALF * K * 2;
    const size_t tstep = 2 * hstep;
    const unsigned ldsw = (unsigned)wid * 1024u;
    const int aoff = lds_byte(wr * 64 + fr, fq * 8), boff = lds_byte(wc * 32 + fr, fq * 8);
#define PG8_SA(b, h) (((b) * 2 + (h)) * HTB)
#define PG8_SB(b, h) ((4 + (b) * 2 + (h)) * HTB)
#define PG8_STAGE(bufoff, gbase, voff) do { _Pragma("unroll") for (int _i = 0; _i < 2; ++_i) \
        __builtin_amdgcn_global_load_lds((const unsigned*)((const char*)(gbase) + (voff)[_i]), (PG8_LAS unsigned*)(lds + (bufoff) + ldsw + _i * 8192), 16, 0, 0); } while (0)
#define PG8_LDA(dst, b, h) do { _Pragma("unroll") for (int m = 0; m < 4; ++m) _Pragma("unroll") for (int k = 0; k < 2; ++k) dst[m][k] = *(const PG8_LAS bf16x8*)(lds + PG8_SA(b, h) + aoff + m * 2048 + k * 1024); } while (0)
#define PG8_LDB(dst, b, h) do { _Pragma("unroll") for (int n = 0; n < 2; ++n) _Pragma("unroll") for (int k = 0; k < 2; ++k) dst[n][k] = *(const PG8_LAS bf16x8*)(lds + PG8_SB(b, h) + boff + n * 2048 + k * 1024); } while (0)
#define PG8_MMA(ai, bj, At, Bt) do { __builtin_amdgcn_s_setprio(1); _Pragma("unroll") for (int m = 0; m < 4; ++m) _Pragma("unroll") for (int n = 0; n < 2; ++n) _Pragma("unroll") for (int k = 0; k < 2; ++k) \
        acc[ai][bj][m][n] = __builtin_amdgcn_mfma_f32_16x16x32_bf16(Bt[n][k], At[m][k], acc[ai][bj][m][n], 0, 0, 0); __builtin_amdgcn_s_setprio(0); } while (0)
#define PG8_WAIT_V(n) asm volatile("s_waitcnt vmcnt(" #n ")" ::: "memory")
#define PG8_WAIT_L(n) asm volatile("s_waitcnt lgkmcnt(" #n ")" ::: "memory")
#define PG8_BAR __builtin_amdgcn_s_barrier()
#define PG8_SCHED __builtin_amdgcn_sched_barrier(0)
    Unit cur, nxt; int ui = 0;
    if (!S.next(0, cur)) return;
    f32x4 acc[2][2][4][2];
#pragma unroll
    for (int a = 0; a < 2; ++a)
#pragma unroll
        for (int b = 0; b < 2; ++b)
#pragma unroll
            for (int m = 0; m < 4; ++m)
#pragma unroll
                for (int n = 0; n < 2; ++n) acc[a][b][m][n] = (f32x4){0.f, 0.f, 0.f, 0.f};
    bf16x8 At[4][2], B0[2][2], B1[2][2];
    const char* cA = (const char*)g.A + (size_t)cur.pm * tstep + (size_t)cur.kt0 * kstep; const char* cB = (const char*)g.Bt + (size_t)cur.pn * tstep + (size_t)cur.kt0 * kstep;
    S.a_ready(cur);
    if constexpr (SP2) {
        PG8_STAGE(PG8_SB(0, 0), cB, voffB); PG8_STAGE(PG8_SB(0, 1), cB + hstep, voffB); PG8_STAGE(PG8_SA(0, 0), cA, voffA); PG8_STAGE(PG8_SA(0, 1), cA + hstep, voffA);
        if (wr == 1) PG8_BAR;
        PG8_WAIT_V(2); PG8_BAR;
        PG8_STAGE(PG8_SB(1, 0), cB + kstep, voffB); PG8_STAGE(PG8_SA(1, 0), cA + kstep, voffA); PG8_STAGE(PG8_SB(1, 1), cB + hstep + kstep, voffB);
        PG8_WAIT_V(6); PG8_BAR;
    } else {
        PG8_STAGE(PG8_SB(0, 0), cB, voffB); PG8_STAGE(PG8_SA(0, 0), cA, voffA); PG8_STAGE(PG8_SB(0, 1), cB + hstep, voffB); PG8_STAGE(PG8_SA(0, 1), cA + hstep, voffA);
        if (wr == 1) PG8_BAR;
        PG8_WAIT_V(4); PG8_BAR;
        PG8_STAGE(PG8_SB(1, 0), cB + kstep, voffB); PG8_STAGE(PG8_SA(1, 0), cA + kstep, voffA); PG8_STAGE(PG8_SB(1, 1), cB + hstep + kstep, voffB);
        PG8_WAIT_V(6); PG8_BAR;
    }
    for (;;) {
        const bool has_next = S.next(ui + 1, nxt);
        const char* nA = has_next ? (const char*)g.A + (size_t)nxt.pm * tstep + (size_t)nxt.kt0 * kstep : cA; const char* nB = has_next ? (const char*)g.Bt + (size_t)nxt.pn * tstep + (size_t)nxt.kt0 * kstep : cB;
        const int nt = cur.nkt;
        for (int t = 0; t < nt; t += 2) {
            const bool last = (t == nt - 2);
            const char* a1 = cA + (size_t)(t + 1) * kstep;
            const char* a2 = last ? nA : cA + (size_t)(t + 2) * kstep; const char* b2 = last ? nB : cB + (size_t)(t + 2) * kstep;
            const char* a3 = a2 + kstep; const char* b3 = b2 + kstep;
            if (last && has_next) S.a_ready(nxt);
            if constexpr (SP2) {
            PG8_LDB(B0, 0, 0); PG8_LDB(B1, 0, 1); PG8_SCHED; PG8_LDA(At, 0, 0); PG8_STAGE(PG8_SA(1, 1), a1 + hstep, voffA);
            PG8_WAIT_V(8); PG8_WAIT_L(0); PG8_BAR; PG8_MMA(0, 0, At, B0); PG8_MMA(0, 1, At, B1); PG8_BAR; PG8_SCHED;
            PG8_LDA(At, 0, 1); PG8_STAGE(PG8_SB(0, 0), b2, voffB); PG8_STAGE(PG8_SB(0, 1), b2 + hstep, voffB); PG8_STAGE(PG8_SA(0, 0), a2, voffA);
            PG8_WAIT_V(8); PG8_WAIT_L(0); PG8_BAR; PG8_MMA(1, 0, At, B0); PG8_MMA(1, 1, At, B1); PG8_BAR; PG8_SCHED;
            PG8_LDB(B0, 1, 0); PG8_LDB(B1, 1, 1); PG8_SCHED; PG8_LDA(At, 1, 0); PG8_STAGE(PG8_SA(0, 1), a2 + hstep, voffA);
            PG8_WAIT_V(8); PG8_WAIT_L(0); PG8_BAR; PG8_MMA(0, 0, At, B0); PG8_MMA(0, 1, At, B1); PG8_BAR; PG8_SCHED;
            PG8_LDA(At, 1, 1); PG8_STAGE(PG8_SB(1, 0), b3, voffB); PG8_STAGE(PG8_SB(1, 1), b3 + hstep, voffB); PG8_STAGE(PG8_SA(1, 0), a3, voffA);
            PG8_WAIT_V(8); PG8_WAIT_L(0); PG8_BAR; PG8_MMA(1, 0, At, B0); PG8_MMA(1, 1, At, B1); PG8_BAR; PG8_SCHED;
            } else {
            PG8_LDB(B0, 0, 0); PG8_SCHED; PG8_LDA(At, 0, 0); PG8_STAGE(PG8_SA(1, 1), a1 + hstep, voffA);
            PG8_WAIT_L(8); PG8_BAR; PG8_WAIT_L(0); PG8_MMA(0, 0, At, B0); PG8_BAR; PG8_SCHED;
            PG8_LDB(B1, 0, 1); PG8_STAGE(PG8_SB(0, 0), b2, voffB);
            PG8_BAR; PG8_WAIT_L(0); PG8_MMA(0, 1, At, B1); PG8_BAR;
            PG8_LDA(At, 0, 1); PG8_STAGE(PG8_SA(0, 0), a2, voffA);
            PG8_BAR; PG8_WAIT_L(0); PG8_MMA(1, 0, At, B0); PG8_BAR; PG8_SCHED;
            PG8_STAGE(PG8_SB(0, 1), b2 + hstep, voffB);
            PG8_WAIT_V(6); PG8_BAR; PG8_MMA(1, 1, At, B1); PG8_BAR;
            PG8_LDB(B0, 1, 0); PG8_SCHED; PG8_LDA(At, 1, 0); PG8_STAGE(PG8_SA(0, 1), a2 + hstep, voffA);
            PG8_WAIT_L(8); PG8_BAR; PG8_WAIT_L(0); PG8_MMA(0, 0, At, B0); PG8_BAR; PG8_SCHED;
            PG8_LDB(B1, 1, 1); PG8_STAGE(PG8_SB(1, 0), b3, voffB);
            PG8_BAR; PG8_WAIT_L(0); PG8_MMA(0, 1, At, B1); PG8_BAR;
            PG8_LDA(At, 1, 1); PG8_STAGE(PG8_SA(1, 0), a3, voffA);
            PG8_BAR; PG8_WAIT_L(0); PG8_MMA(1, 0, At, B0); PG8_BAR; PG8_SCHED;
            PG8_STAGE(PG8_SB(1, 1), b3 + hstep, voffB);
            PG8_WAIT_V(6); PG8_BAR; PG8_MMA(1, 1, At, B1); PG8_BAR;
            }
        }
        if constexpr (ALIGN_EPI) { if (wr == 0) PG8_BAR; }
        if constexpr (!Epi::AFTER_DRAIN) { E(acc, cur, wr, wc, fr, fq); S.done(cur); }
        if (!has_next) break;
#pragma unroll
        for (int a = 0; a < 2; ++a)
#pragma unroll
            for (int b = 0; b < 2; ++b)
#pragma unroll
                for (int m = 0; m < 4; ++m)
#pragma unroll
                    for (int n = 0; n < 2; ++n) acc[a][b][m][n] = (f32x4){0.f, 0.f, 0.f, 0.f};
        cur = nxt; cA = nA; cB = nB; ++ui;
        if constexpr (ALIGN_EPI) { if (wr == 1) PG8_BAR; }
    }
    PG8_WAIT_V(0);
    if constexpr (!ALIGN_EPI) { if (wr == 0) PG8_BAR; }
    PG8_BAR;
    if constexpr (Epi::AFTER_DRAIN) { E.fused(acc, cur, wr, wc, fr, fq, lds, wid, lane); S.done(cur); }
#undef PG8_SA
#undef PG8_SB
#undef PG8_STAGE
#undef PG8_LDA
#undef PG8_LDB
#undef PG8_MMA
#undef PG8_WAIT_V
#undef PG8_WAIT_L
#undef PG8_BAR
#undef PG8_SCHED
}
}
#define XB_TMO      128
#define XB_XCNT(j)  (256  + 64 * (j))
#define XB_XSUB(j)  (1280 + 64 * (j))
#define XB_XGEN(j)  (2304 + 64 * (j))
#define XB_TOP      3328
#define XB_TOPGEN   3392
#define XCD_BAR_WORDS 3456
#define XB_SPIN_CAP (1u << 18)

__device__ __forceinline__ unsigned xb_ld(unsigned* p)              { return __hip_atomic_load(p, __ATOMIC_RELAXED, __HIP_MEMORY_SCOPE_AGENT); }
__device__ __forceinline__ unsigned xb_add(unsigned* p, unsigned v) { return __hip_atomic_fetch_add(p, v, __ATOMIC_RELAXED, __HIP_MEMORY_SCOPE_AGENT); }
__device__ __forceinline__ unsigned xb_xcc_id() { return (unsigned)__builtin_amdgcn_s_getreg((3 << 11) | 20) & 0xFu; }
#define XB_SPIN(cond, bar) do { unsigned _sp = 0; while (cond) { __builtin_amdgcn_s_sleep(1); \
    if ((++_sp & 255u) == 0u) { if (xb_ld(&(bar)[XB_TMO])) break; if (_sp > XB_SPIN_CAP) { atomicAdd(&(bar)[XB_TMO], 1u); break; } } } } while (0)

struct XcdBarrier {
    unsigned* bar; unsigned x;
    volatile LAS unsigned* st;
};

__device__ __forceinline__ XcdBarrier xcd_barrier_post(unsigned* bar, volatile LAS unsigned* st, int tid) {
    XcdBarrier b; b.bar = bar; b.x = xb_xcc_id(); b.st = st;
    if (tid == 0) (void)xb_add(&bar[XB_XCNT(b.x)], 1u);
    return b;
}
__device__ __forceinline__ void xcd_barrier_complete(unsigned* bar, unsigned x, unsigned& nloc, unsigned& nx) {
    const unsigned G = gridDim.x * gridDim.y * gridDim.z;
    unsigned sum, cnt, mine, sp = 0u;
    for (;;) {
        sum = 0u; cnt = 0u; mine = 0u;
#pragma unroll
        for (unsigned j = 0; j < 16; ++j) { const unsigned c = xb_ld(&bar[XB_XCNT(j)]); sum += c; cnt += (c > 0u) ? 1u : 0u; mine = (j == x) ? c : mine; }
        if (sum == G) break;
        __builtin_amdgcn_s_sleep(1);
        if ((++sp & 255u) == 0u) { if (xb_ld(&bar[XB_TMO])) break; if (sp > XB_SPIN_CAP) { atomicAdd(&bar[XB_TMO], 1u); break; } }
    }
    nloc = mine > 0u ? mine : 1u; nx = cnt > 0u ? cnt : 1u;
}

__device__ __forceinline__ void xcd_barrier(const XcdBarrier& b, int tid) {
    asm volatile("s_waitcnt vmcnt(0)" ::: "memory");
    __syncthreads();
    if (tid == 0) {
        unsigned* bar = b.bar;
        __builtin_amdgcn_s_waitcnt(0);
        unsigned nloc = b.st[0], nx = b.st[1];
        if (nloc == 0u) { xcd_barrier_complete(bar, b.x, nloc, nx); b.st[0] = nloc; b.st[1] = nx; }
        const unsigned old = xb_add(&bar[XB_XSUB(b.x)], 1u);
        const unsigned gen = old / nloc;
        if (old + 1u == (gen + 1u) * nloc) {
            __builtin_amdgcn_fence(__ATOMIC_RELEASE, "agent");
            asm volatile("s_waitcnt vmcnt(0)" ::: "memory");
            const unsigned og = xb_add(&bar[XB_TOP], 1u);
            const unsigned tg = og / nx;
            if (og + 1u == (tg + 1u) * nx) xb_add(&bar[XB_TOPGEN], 1u);
            else XB_SPIN(xb_ld(&bar[XB_TOPGEN]) == tg, bar);
            __builtin_amdgcn_fence(__ATOMIC_ACQUIRE, "agent");
            xb_add(&bar[XB_XGEN(b.x)], 1u);
            asm volatile("s_waitcnt vmcnt(0)" ::: "memory");
        } else {
            XB_SPIN(xb_ld(&bar[XB_XGEN(b.x)]) == gen, bar);
            __builtin_amdgcn_fence(__ATOMIC_ACQUIRE, "agent");
            asm volatile("s_waitcnt vmcnt(0)" ::: "memory");
        }
    }
    __syncthreads();
}
constexpr int NWAVES = 8;
constexpr int D = 2048, FF = 5632, SEQ = 2048, NB = 4, NSB = 128;
constexpr int TPROMPT = NB * SEQ;
constexpr int T = TPROMPT + NSB;
constexpr int TP = 8448;
constexpr int DEPTH = 4;
constexpr float EPS = 1e-6f;
constexpr int NSPLIT_D = 22;
constexpr int CAW = 31, CCW = 3, DSGU = 4096, CHUNK = 128, NG = 8, DG = 512;
constexpr size_t O_YP = 0, O_YS = 16777216, O_AP = 17039360, O_AS = 17530880, O_VP = 33259520, O_VS = 35356672, O_CP = 35880960, O_CS = 35897344, O_END = 36421632;
constexpr size_t MiB = 1u << 20;
constexpr size_t WS_CTL = 0, CTL_ZERO_BYTES = 1 * MiB;
constexpr size_t WS_WSB = 1 * MiB;
constexpr size_t WS_WGU = 2 * MiB, SZ_WGU = 44 * MiB;
constexpr size_t WS_WD = 354 * MiB, SZ_WD = 22 * MiB;
constexpr size_t WS_WA1 = 530 * MiB, SZ_WA1 = 16 * MiB;
constexpr size_t WS_WA2 = 562 * MiB, SZ_WA2 = 8 * MiB;
constexpr size_t WS_WB1 = 578 * MiB, WS_WB2 = 610 * MiB;
constexpr size_t WS_WC1 = 626 * MiB, WS_WC2 = 650 * MiB;
constexpr size_t WS_X = 658 * MiB;
constexpr size_t WS_XN = 724 * MiB;
constexpr size_t WS_ACT = 757 * MiB;
constexpr size_t WS_Y = 889 * MiB;
constexpr size_t WS_SLAB = 955 * MiB;
constexpr size_t WS_PS = 989 * MiB;
constexpr size_t WS_RS = 991 * MiB;
constexpr size_t WS_END = 992 * MiB;
constexpr int CW_BAR = 4096;
constexpr int RING_BYTES = 131072, LDSCTL_OFF = RING_BYTES, MISC_OFF = LDSCTL_OFF + 320, LDS_BYTES = 147456;

typedef unsigned short bf16;
typedef float f32x4 __attribute__((ext_vector_type(4)));
typedef unsigned u32x4v __attribute__((ext_vector_type(4)));
typedef unsigned u32x2v __attribute__((ext_vector_type(2)));
typedef short bf16x8 __attribute__((ext_vector_type(8)));
typedef short s16x4 __attribute__((ext_vector_type(4)));
#define LDS_WAIT() asm volatile("s_waitcnt lgkmcnt(0)" ::: "memory")
#define VM_WAIT() asm volatile("s_waitcnt vmcnt(0)" ::: "memory")

__device__ __forceinline__ unsigned pk_bf16(float lo, float hi) { return pg8::cvt_pk_bf16(lo, hi); }
__device__ __forceinline__ f32x4 bf4_to_f32(u32x2v v) { f32x4 r; r.x = __uint_as_float(v.x << 16); r.y = __uint_as_float(v.x & 0xffff0000u); r.z = __uint_as_float(v.y << 16); r.w = __uint_as_float(v.y & 0xffff0000u); return r; }
__device__ __forceinline__ u32x2v f32_to_bf4(f32x4 v) { u32x2v r; r.x = pk_bf16(v.x, v.y); r.y = pk_bf16(v.z, v.w); return r; }
__device__ __forceinline__ float wave_sum(float v, int lane) {
#pragma unroll
    for (int o = 1; o < 64; o <<= 1) v += __builtin_bit_cast(float, __builtin_amdgcn_ds_bpermute((lane ^ o) << 2, __builtin_bit_cast(int, v)));
    return v;
}
__device__ __forceinline__ float silu_f(float x) { return x * pg8::sigmoid_f(x); }

struct Args { const float* in[28]; float* out; unsigned char* ws; };
typedef const __attribute__((address_space(4))) char* kargp_t;
__device__ __forceinline__ kargp_t karg_base() { kargp_t k = (kargp_t)__builtin_amdgcn_kernarg_segment_ptr(); asm volatile("" : "+s"(k)); return k; }
__device__ __forceinline__ const float* inp(int i) { return *(const float* const __attribute__((address_space(4)))*)(karg_base() + 8 * i); }
__device__ __forceinline__ float* outp() { return *(float* const __attribute__((address_space(4)))*)(karg_base() + 8 * 28); }
__device__ __forceinline__ unsigned char* wsp() { return *(unsigned char* const __attribute__((address_space(4)))*)(karg_base() + 8 * 29); }

struct Frame {
    LAS unsigned char* lds;
    int wave0;
    int tid, lane, wave, vcu, G, gw, NGW;
};

__device__ __forceinline__ int lane_id_asm() { int l; asm volatile("v_mbcnt_lo_u32_b32 %0, -1, 0\n\tv_mbcnt_hi_u32_b32 %0, -1, %0" : "=v"(l)); return l; }
__device__ __forceinline__ void relaunder(Frame& F) {
    int w = F.wave0, bx = blockIdx.x, G = gridDim.x; asm volatile("" : "+s"(w), "+s"(bx), "+s"(G));
    F.lane = lane_id_asm(); F.wave = w; F.tid = w * 64 + F.lane;
    F.G = G; F.vcu = (G % 8 == 0) ? (bx % 8) * (G / 8) + bx / 8 : bx;
    F.gw = F.vcu * NWAVES + F.wave; F.NGW = G * NWAVES;
}
__device__ __forceinline__ void transpose_item(const float* W, int ld, int K, bf16* WT, int k0, int n0, int drow0, const float* gk, LAS float* scr, int lane) {
    f32x4 v[8];
#pragma unroll
    for (int i = 0; i < 8; ++i) v[i] = *(const f32x4*)(W + (size_t)(k0 + 8 * i + (lane >> 3)) * ld + n0 + 4 * (lane & 7));
    if (gk) {
#pragma unroll
        for (int i = 0; i < 8; ++i) v[i] = v[i] * gk[k0 + 8 * i + (lane >> 3)]; }
#pragma unroll
    for (int i = 0; i < 8; ++i) { LAS float* s = scr + (8 * i + (lane >> 3)) * 33 + 4 * (lane & 7); s[0] = v[i].x; s[1] = v[i].y; s[2] = v[i].z; s[3] = v[i].w; }
    LDS_WAIT(); asm volatile("" ::: "memory");
    const int c = lane & 7;
#pragma unroll
    for (int j = 0; j < 4; ++j) { const int n = (lane >> 3) + 8 * j; const LAS float* s = scr + (8 * c) * 33 + n;
        u32x4v o; o.x = pk_bf16(s[0 * 33], s[1 * 33]); o.y = pk_bf16(s[2 * 33], s[3 * 33]); o.z = pk_bf16(s[4 * 33], s[5 * 33]); o.w = pk_bf16(s[6 * 33], s[7 * 33]);
        *(u32x4v*)(WT + (size_t)(drow0 + n) * K + k0 + 8 * c) = o; }
    LDS_WAIT(); asm volatile("" ::: "memory");
}
__device__ __forceinline__ void transpose_job(const float* W, int ld, int K, int N, bf16* WT, int mode, int roff, int item, const float* gk, LAS float* scr, int lane) {
    const int nblk = N >> 5, kb = item / nblk, nb = item - kb * nblk, n0 = nb << 5;
    const int drow0 = roff + (mode ? ((n0 >> 7) * 256 + (n0 & 127)) : n0);
    transpose_item(W, ld, K, WT, kb * 64, n0, drow0, gk, scr, lane);
}
constexpr int NDEF_PER_WG = 96, NDEF_WGS = 84, NDEF = NDEF_PER_WG * NDEF_WGS;
__device__ __forceinline__ void ffn_item(int f, int rr, LAS float* scr, int lane) {
    constexpr int I_FF = (D / 64) * (FF / 32);
    unsigned char* ws = wsp(); const int which = rr / I_FF, item = rr - which * I_FF;
    const float* gk = ((f & 1) ? inp(6) : inp(4)) + (size_t)(f >> 1) * D;
    if (which == 0)      transpose_job(inp(8) + (size_t)f * D * FF, FF, D, FF, (bf16*)(ws + WS_WGU + f * SZ_WGU), 1, 0, item, gk, scr, lane);
    else if (which == 1) transpose_job(inp(9) + (size_t)f * D * FF, FF, D, FF, (bf16*)(ws + WS_WGU + f * SZ_WGU), 1, 128, item, gk, scr, lane);
    else                 transpose_job(inp(10) + (size_t)f * FF * D, D, FF, D, (bf16*)(ws + WS_WD + f * SZ_WD), 0, 0, item, nullptr, scr, lane);
}
__device__ __forceinline__ void ffn_deferred(Frame& F, int f) {
    relaunder(F);
    int bx = blockIdx.x, G = gridDim.x; asm volatile("" : "+s"(bx), "+s"(G));
    if (G != 256) { if (bx < NDEF_WGS) { LAS float* scr = (LAS float*)(F.lds + F.wave * 16384);
            for (int i = F.wave; i < NDEF_PER_WG; i += NWAVES) ffn_item(f, bx * NDEF_PER_WG + i, scr, F.lane); } return; }
    if (bx < 256 - NDEF_WGS) return;
    LAS float* scr = (LAS float*)(F.lds + F.wave * 16384);
    const int r0 = (bx - (256 - NDEF_WGS)) * NDEF_PER_WG;
    for (int i = F.wave; i < NDEF_PER_WG; i += NWAVES) ffn_item(f, r0 + i, scr, F.lane);
}
__device__ __forceinline__ void phase_prologue(Frame& F) {
    relaunder(F);
    LAS float* scr = (LAS float*)(F.lds + F.wave * 16384);
    constexpr int I_FF = (D / 64) * (FF / 32);
    constexpr int I_A1H = (D / 64) * (D / 32);
    constexpr int I_B1 = (D / 64) * (8192 / 32);
    constexpr int I_B2 = (DSGU / 64) * (D / 32);
    constexpr int N_FFN = 8 * 3 * I_FF, N_A = 2 * 3 * I_A1H, N_B = I_B1 + I_B2, N_C = 4 * I_A1H;
    constexpr int NITEMS = N_FFN + N_A + N_B + N_C;
    unsigned char* ws = wsp();
    for (int it = F.gw; it < NITEMS; it += F.NGW) {
        int r = it;
        if (r < N_FFN) { const int f = r / (3 * I_FF), rr = r - f * 3 * I_FF, which = rr / I_FF, item = rr - which * I_FF;
            if (f >= 1 && rr < NDEF) continue;
            const float* gk = ((f & 1) ? inp(6) : inp(4)) + (size_t)(f >> 1) * D;
            if (which == 0)      transpose_job(inp(8) + (size_t)f * D * FF, FF, D, FF, (bf16*)(ws + WS_WGU + f * SZ_WGU), 1, 0, item, gk, scr, F.lane);
            else if (which == 1) transpose_job(inp(9) + (size_t)f * D * FF, FF, D, FF, (bf16*)(ws + WS_WGU + f * SZ_WGU), 1, 128, item, gk, scr, F.lane);
            else                 transpose_job(inp(10) + (size_t)f * FF * D, D, FF, D, (bf16*)(ws + WS_WD + f * SZ_WD), 0, 0, item, nullptr, scr, F.lane);
            continue; }
        r -= N_FFN;
        if (r < N_A) { const int j = r / (3 * I_A1H), rr = r - j * 3 * I_A1H, which = rr / I_A1H, item = rr - which * I_A1H;
            const float* gk = inp(5) + (size_t)(3 * j) * D;
            if (which == 0)      transpose_job(inp(11) + (size_t)j * D * 4096, 4096, D, D, (bf16*)(ws + WS_WA1 + j * SZ_WA1), 1, 0, item, gk, scr, F.lane);
            else if (which == 1) transpose_job(inp(11) + (size_t)j * D * 4096 + 2048, 4096, D, D, (bf16*)(ws + WS_WA1 + j * SZ_WA1), 1, 128, item, gk, scr, F.lane);
            else                 transpose_job(inp(17) + (size_t)j * D * D, D, D, D, (bf16*)(ws + WS_WA2 + j * SZ_WA2), 0, 0, item, nullptr, scr, F.lane);
            continue; }
        r -= N_A;
        if (r < N_B) {
            if (r < I_B1) transpose_job(inp(18), 8192, D, 8192, (bf16*)(ws + WS_WB1), 0, 0, r, inp(5) + (size_t)1 * D, scr, F.lane);
            else          transpose_job(inp(24), D, DSGU, D, (bf16*)(ws + WS_WB2), 0, 0, r - I_B1, nullptr, scr, F.lane);
            continue; }
        r -= N_B;
        { const int which = r / I_A1H, item = r - which * I_A1H;
            const float* gk = inp(5) + (size_t)2 * D;
            if (which == 0)      transpose_job(inp(25), 6144, D, D, (bf16*)(ws + WS_WC1), 0, 4096, item, gk, scr, F.lane);
            else if (which == 1) transpose_job(inp(25) + 2048, 6144, D, D, (bf16*)(ws + WS_WC1), 1, 0, item, gk, scr, F.lane);
            else if (which == 2) transpose_job(inp(25) + 4096, 6144, D, D, (bf16*)(ws + WS_WC1), 1, 128, item, gk, scr, F.lane);
            else                 transpose_job(inp(27), D, D, D, (bf16*)(ws + WS_WC2), 0, 0, item, nullptr, scr, F.lane); }
    }
    { const float* wsrc = inp(22); bf16* wsb = (bf16*)(ws + WS_WSB);
      for (int i = F.gw * 64 + F.lane; i < NG * CHUNK * CHUNK; i += F.NGW * 64) { const int s = i & 127, t = (i >> 7) & 127; const float v = (s <= t) ? wsrc[i] : 0.f; wsb[i] = (bf16)(pk_bf16(v, 0.f) & 0xffffu); } }
}

__device__ __forceinline__ void phase_init(Frame& F) {
    relaunder(F);
    float* X = (float*)(wsp() + WS_X); bf16* XB = (bf16*)(wsp() + WS_XN); float* RS = (float*)(wsp() + WS_RS);
    for (int m = F.gw; m < T; m += F.NGW) {
        const float* src = (m < TPROMPT) ? inp(0) + (size_t)m * D : inp(1) + (size_t)(m - TPROMPT) * D;
        f32x4 v[8]; float s = 0.f;
#pragma unroll
        for (int j = 0; j < 8; ++j) { v[j] = ((const f32x4*)src)[64 * j + F.lane]; s += (v[j].x * v[j].x + v[j].y * v[j].y) + (v[j].z * v[j].z + v[j].w * v[j].w); }
#pragma unroll
        for (int j = 0; j < 8; ++j) { ((f32x4*)(X + (size_t)m * D))[64 * j + F.lane] = v[j]; ((u32x2v*)(XB + (size_t)m * D))[64 * j + F.lane] = f32_to_bf4(v[j]); }
        const float rs = 1.0f / sqrtf(wave_sum(s, F.lane) * (1.0f / D) + EPS);
        if (F.lane == 0) RS[m] = rs;
    }
}
__device__ __forceinline__ void phase_fix(Frame& F, int nsplit, float scale) {
    relaunder(F);
    float* X = (float*)(wsp() + WS_X); bf16* XB = (bf16*)(wsp() + WS_XN); float* RS = (float*)(wsp() + WS_RS); const float* PS = (const float*)(wsp() + WS_PS);
    for (int m = F.vcu * (NWAVES * 64) + F.tid; m < TPROMPT; m += F.G * (NWAVES * 64)) {
        const f32x4* p = (const f32x4*)(PS + (size_t)m * 32); f32x4 a = p[0];
#pragma unroll
        for (int i = 1; i < 8; ++i) a += p[i];
        RS[m] = 1.0f / sqrtf(((a.x + a.y) + (a.z + a.w)) * (1.0f / D) + EPS);
    }
    LAS float* red = (LAS float*)F.lds;
    for (int bq = F.vcu; bq < NSB; bq += F.G) {
        const size_t m = TPROMPT + bq; const int c0 = 4 * F.tid;
        const float* sl = (const float*)(wsp() + WS_SLAB) + (size_t)bq * D + c0;
        f32x4 part[22];
#pragma unroll
        for (int sp = 0; sp < 22; ++sp) { part[sp] = (f32x4){0.f, 0.f, 0.f, 0.f}; if (sp < nsplit) part[sp] = *(const f32x4*)(sl + (size_t)sp * 128 * D); }
        f32x4 x = *(const f32x4*)(X + m * D + c0);
#pragma unroll
        for (int sp = 0; sp < 22; ++sp) x += part[sp] * scale;
        *(f32x4*)(X + m * D + c0) = x; *(u32x2v*)(XB + m * D + c0) = f32_to_bf4(x);
        const float s = wave_sum((x.x * x.x + x.y * x.y) + (x.z * x.z + x.w * x.w), F.lane);
        __syncthreads();
        if (F.lane == 0) red[F.wave] = s;
        __syncthreads();
        if (F.tid == 0) { float t = 0.f;
#pragma unroll
            for (int w = 0; w < NWAVES; ++w) t += red[w];
            RS[m] = 1.0f / sqrtf(t * (1.0f / D) + EPS); }
    }
}
__device__ __forceinline__ void phase_final(Frame& F) {
    relaunder(F);
    const float* X = (const float*)(wsp() + WS_X); const float* g = inp(7);
    f32x4 gv[8];
#pragma unroll
    for (int j = 0; j < 8; ++j) gv[j] = ((const f32x4*)g)[64 * j + F.lane];
    for (int m = F.gw; m < T; m += F.NGW) {
        f32x4 v[8]; float s = 0.f;
#pragma unroll
        for (int j = 0; j < 8; ++j) v[j] = ((const f32x4*)(X + (size_t)m * D))[64 * j + F.lane];
        if (m >= TPROMPT) { const float* sl = (const float*)(wsp() + WS_SLAB) + (size_t)(m - TPROMPT) * D;
#pragma unroll
            for (int j = 0; j < 8; ++j) { f32x4 p[NSPLIT_D];
#pragma unroll
                for (int sp = 0; sp < NSPLIT_D; ++sp) p[sp] = ((const f32x4*)(sl + (size_t)sp * 128 * D))[64 * j + F.lane];
#pragma unroll
                for (int sp = 0; sp < NSPLIT_D; ++sp) v[j] += p[sp] * 0.5f; } }
#pragma unroll
        for (int j = 0; j < 8; ++j) s += (v[j].x * v[j].x + v[j].y * v[j].y) + (v[j].z * v[j].z + v[j].w * v[j].w);
        const float rs = 1.0f / sqrtf(wave_sum(s, F.lane) * (1.0f / D) + EPS);
        f32x4* o = (f32x4*)(outp() + O_YP + (size_t)m * D) + F.lane;
#pragma unroll
        for (int j = 0; j < 8; ++j) o[64 * j] = (v[j] * rs) * gv[j];
    }
}

template <int R> __device__ __forceinline__ void ln_silu_store(Frame& F, f32x4 (&acc)[R], const f32x4 g, const f32x4 b, bf16* y0  , LAS float* red) {
    float s[R];
#pragma unroll
    for (int r = 0; r < R; ++r) s[r] = wave_sum((acc[r].x + acc[r].y) + (acc[r].z + acc[r].w), F.lane);
    if (F.lane == 0) {
#pragma unroll
        for (int r = 0; r < R; ++r) red[F.wave * R + r] = s[r]; }
    __syncthreads();
    float mu[R];
#pragma unroll
    for (int r = 0; r < R; ++r) { float t = 0.f;
#pragma unroll
        for (int w = 0; w < NWAVES; ++w) t += red[w * R + r];
        mu[r] = t * (1.0f / D); }
#pragma unroll
    for (int r = 0; r < R; ++r) { const f32x4 d = acc[r] - mu[r]; s[r] = wave_sum((d.x * d.x + d.y * d.y) + (d.z * d.z + d.w * d.w), F.lane); }
    LAS float* red2 = red + NWAVES * R;
    if (F.lane == 0) {
#pragma unroll
        for (int r = 0; r < R; ++r) red2[F.wave * R + r] = s[r]; }
    __syncthreads();
#pragma unroll
    for (int r = 0; r < R; ++r) { float t = 0.f;
#pragma unroll
        for (int w = 0; w < NWAVES; ++w) t += red2[w * R + r];
        const float rstd = 1.0f / sqrtf(t * (1.0f / D) + EPS);
        f32x4 y = ((acc[r] - mu[r]) * rstd) * g + b;
        y.x = silu_f(y.x); y.y = silu_f(y.y); y.z = silu_f(y.z); y.w = silu_f(y.w);
        *(u32x2v*)(y0 + (size_t)r * D) = f32_to_bf4(y); }
}
__device__ __forceinline__ void phase_convA(Frame& F, int j) {
    relaunder(F);
    const float* wdw = inp(13) + (size_t)j * CAW * D; const float* st = inp(2) + (size_t)j * NSB * 30 * D;
    const bf16* GLU = (const bf16*)(wsp() + WS_ACT); bf16* Y = (bf16*)(wsp() + WS_Y);
    LAS float* red = (LAS float*)F.lds;
    const int c0 = 4 * F.tid;
    const f32x4 bd = *(const f32x4*)(inp(14) + (size_t)j * D + c0), lg = *(const f32x4*)(inp(15) + (size_t)j * D + c0), lb = *(const f32x4*)(inp(16) + (size_t)j * D + c0);
    for (int it = F.vcu; it < TPROMPT / 8; it += F.G) {
        const int bq = it >> 8, t0 = (it & 255) * 8; const size_t m0 = (size_t)bq * SEQ + t0;
        u32x2v x[38];
#pragma unroll
        for (int i = 0; i < 38; ++i) { const int t = t0 - 30 + i; x[i] = (u32x2v){0u, 0u}; if (t >= 0) x[i] = *(const u32x2v*)(GLU + ((size_t)bq * SEQ + t) * D + c0); }
        f32x4 acc[8];
#pragma unroll
        for (int r = 0; r < 8; ++r) acc[r] = bd;
        f32x4 wk[2][4];
#pragma unroll
        for (int kk = 0; kk < 4; ++kk) wk[0][kk] = *(const f32x4*)(wdw + (size_t)kk * D + c0);
#pragma unroll
        for (int kb = 0; kb < 32; kb += 4) {
#pragma unroll
            for (int kk = 0; kk < 4; ++kk) if (kb + 4 + kk < CAW) wk[((kb >> 2) + 1) & 1][kk] = *(const f32x4*)(wdw + (size_t)(kb + 4 + kk) * D + c0);
            asm volatile("" ::: "memory");
#pragma unroll
            for (int kk = 0; kk < 4; ++kk) if (kb + kk < CAW) {
#pragma unroll
                for (int r = 0; r < 8; ++r) acc[r] += wk[(kb >> 2) & 1][kk] * bf4_to_f32(x[r + kb + kk]); }
        }
        ln_silu_store<8>(F, acc, lg, lb, Y + m0 * D + c0, red);
    }
    for (int it = F.vcu; it < NSB; it += F.G) {
        const size_t m = TPROMPT + it;
        f32x4 acc[1]; acc[0] = bd;
#pragma unroll
        for (int kb = 0; kb < 30; kb += 6) { f32x4 xs[6], wk[6];
#pragma unroll
            for (int kk = 0; kk < 6; ++kk) { xs[kk] = *(const f32x4*)(st + ((size_t)it * 30 + kb + kk) * D + c0); wk[kk] = *(const f32x4*)(wdw + (size_t)(kb + kk) * D + c0); }
            asm volatile("" ::: "memory");
#pragma unroll
            for (int kk = 0; kk < 6; ++kk) acc[0] += wk[kk] * xs[kk]; }
        { const float* sl = (const float*)(wsp() + WS_SLAB) + (size_t)it * 4096 + (c0 >> 7) * 256 + (c0 & 127);
          f32x4 av = (f32x4){0.f, 0.f, 0.f, 0.f}, gt = av; const float rs = ((const float*)(wsp() + WS_RS))[m];
#pragma unroll
          for (int sp = 0; sp < 8; ++sp) { av += *(const f32x4*)(sl + (size_t)sp * 128 * 4096); gt += *(const f32x4*)(sl + (size_t)sp * 128 * 4096 + 128); }
          av = av * rs + *(const f32x4*)(inp(12) + (size_t)j * 4096 + c0); gt = gt * rs + *(const f32x4*)(inp(12) + (size_t)j * 4096 + 2048 + c0);
          f32x4 glu; glu.x = av.x * pg8::sigmoid_f(gt.x); glu.y = av.y * pg8::sigmoid_f(gt.y); glu.z = av.z * pg8::sigmoid_f(gt.z); glu.w = av.w * pg8::sigmoid_f(gt.w);
          *(f32x4*)(outp() + O_AS + ((size_t)(j * NSB + it) * 30 + 29) * D + c0) = glu;
          acc[0] += *(const f32x4*)(wdw + (size_t)30 * D + c0) * glu; }
        ln_silu_store<1>(F, acc, lg, lb, Y + m * D + c0, red);
    }
    for (int idx = F.gw; idx < NB * 30 + NSB * 30; idx += F.NGW) {
        if (idx < NB * 30) { const int bq = idx / 30, i = idx - bq * 30; const bf16* src = GLU + ((size_t)bq * SEQ + SEQ - 30 + i) * D; float* dst = outp() + O_AP + ((size_t)(j * NB + bq) * 30 + i) * D;
#pragma unroll
            for (int q = 0; q < 8; ++q) ((f32x4*)dst)[64 * q + F.lane] = bf4_to_f32(((const u32x2v*)src)[64 * q + F.lane]); }
        else { const int r = idx - NB * 30, bq = r / 30, i = r - bq * 30; float* dst = outp() + O_AS + ((size_t)(j * NSB + bq) * 30 + i) * D;
            if (i < 29) { const float* src = st + ((size_t)bq * 30 + i + 1) * D;
#pragma unroll
                for (int q = 0; q < 8; ++q) ((f32x4*)dst)[64 * q + F.lane] = ((const f32x4*)src)[64 * q + F.lane]; }
        }
    }
}

__device__ __forceinline__ void phase_convC(Frame& F) {
    relaunder(F);
    const bf16* ACT = (const bf16*)(wsp() + WS_ACT); bf16* Y = (bf16*)(wsp() + WS_Y);
    const float* cw = inp(26); const float* st = inp(3);
    f32x4 w0[8], w1[8], w2[8];
#pragma unroll
    for (int q = 0; q < 8; ++q) { w0[q] = ((const f32x4*)cw)[64 * q + F.lane]; w1[q] = ((const f32x4*)(cw + D))[64 * q + F.lane]; w2[q] = ((const f32x4*)(cw + 2 * D))[64 * q + F.lane]; }
    for (int m = F.gw; m < T; m += F.NGW) {
        const bf16* r0 = ACT + (size_t)m * 4096;
#pragma unroll
        for (int q = 0; q < 8; ++q) {
            const int e = 64 * q + F.lane;
            f32x4 cx0, bg, cx1 = (f32x4){0.f, 0.f, 0.f, 0.f}, cx2 = (f32x4){0.f, 0.f, 0.f, 0.f};
            if (m < TPROMPT) { const int t = m & (SEQ - 1);
                cx0 = bf4_to_f32(((const u32x2v*)r0)[e]); bg = bf4_to_f32(((const u32x2v*)(r0 + 2048))[e]);
                if (t >= 1) cx1 = bf4_to_f32(((const u32x2v*)(r0 - 4096))[e]);
                if (t >= 2) cx2 = bf4_to_f32(((const u32x2v*)(r0 - 2 * 4096))[e]); }
            else { const int bq = m - TPROMPT, oc = 4 * e;
                const float* sl = (const float*)(wsp() + WS_SLAB) + (size_t)bq * 6144;
                const int colc = (oc >> 7) * 256 + (oc & 127);
                f32x4 cg = (f32x4){0.f, 0.f, 0.f, 0.f}, xi = cg; bg = cg;
#pragma unroll
                for (int sp = 0; sp < 8; ++sp) { const float* p = sl + (size_t)sp * 128 * 6144; cg += *(const f32x4*)(p + colc); xi += *(const f32x4*)(p + colc + 128); bg += *(const f32x4*)(p + 4096 + oc); }
                { const float rs = ((const float*)(wsp() + WS_RS))[m]; cx0 = (cg * rs) * (xi * rs); bg = bg * rs; }
                cx2 = ((const f32x4*)(st + ((size_t)bq * 2 + 0) * D))[e]; cx1 = ((const f32x4*)(st + ((size_t)bq * 2 + 1) * D))[e];
                ((f32x4*)(outp() + O_CS + ((size_t)bq * 2 + 1) * D))[e] = cx0; }
            const f32x4 y = bg * (w0[q] * cx2 + w1[q] * cx1 + w2[q] * cx0);
            ((u32x2v*)(Y + (size_t)m * D))[e] = f32_to_bf4(y);
        }
    }
    for (int idx = F.gw; idx < NB * 2 + NSB * 2; idx += F.NGW) {
        if (idx < NB * 2) { const int bq = idx >> 1, i = idx & 1; const bf16* src = ACT + ((size_t)bq * SEQ + SEQ - 2 + i) * 4096; float* dst = outp() + O_CP + (size_t)idx * D;
#pragma unroll
            for (int q = 0; q < 8; ++q) ((f32x4*)dst)[64 * q + F.lane] = bf4_to_f32(((const u32x2v*)src)[64 * q + F.lane]); }
        else { const int r = idx - NB * 2, bq = r >> 1, i = r & 1; float* dst = outp() + O_CS + (size_t)r * D;
            if (i == 0) { const float* src = st + ((size_t)bq * 2 + 1) * D;
#pragma unroll
                for (int q = 0; q < 8; ++q) ((f32x4*)dst)[64 * q + F.lane] = ((const f32x4*)src)[64 * q + F.lane]; }
        }
    }
}

__device__ __forceinline__ void phase_sguLN(Frame& F) {
    relaunder(F);
    bf16* Z = (bf16*)(wsp() + WS_ACT); const float* lg = inp(20); const float* lb = inp(21);
    for (int m = F.gw; m < T; m += F.NGW) {
        bf16* vr = Z + (size_t)m * 8192 + DSGU;
        f32x4 v[16]; float s = 0.f;
        if (m < TPROMPT) {
#pragma unroll
            for (int q = 0; q < 8; ++q) { const u32x4v raw = ((const u32x4v*)vr)[64 * q + F.lane];
                v[2 * q] = bf4_to_f32((u32x2v){raw.x, raw.y}); v[2 * q + 1] = bf4_to_f32((u32x2v){raw.z, raw.w}); }
        } else {
            const float* sl = (const float*)(wsp() + WS_SLAB) + (size_t)(m - TPROMPT) * 8192; const float* bias = inp(19); const float rs_s = ((const float*)(wsp() + WS_RS))[m];
#pragma unroll
            for (int half = 0; half < 2; ++half)
#pragma unroll
                for (int q = 0; q < 8; ++q) { const int col = half * DSGU + (64 * q + F.lane) * 8;
                    f32x4 a = (f32x4){0.f, 0.f, 0.f, 0.f}, b = a;
#pragma unroll
                    for (int sp = 0; sp < 8; ++sp) { a += *(const f32x4*)(sl + (size_t)sp * 128 * 8192 + col); b += *(const f32x4*)(sl + (size_t)sp * 128 * 8192 + col + 4); }
                    a = a * rs_s + *(const f32x4*)(bias + col); b = b * rs_s + *(const f32x4*)(bias + col + 4);
                    const pg8::f32x2 g0 = pg8::gelu_pk((pg8::f32x2){a.x, a.y}), g1 = pg8::gelu_pk((pg8::f32x2){a.z, a.w}), g2 = pg8::gelu_pk((pg8::f32x2){b.x, b.y}), g3 = pg8::gelu_pk((pg8::f32x2){b.z, b.w});
                    a = (f32x4){g0.x, g0.y, g1.x, g1.y}; b = (f32x4){g2.x, g2.y, g3.x, g3.y};
                    if (half == 0) { const u32x2v pa = f32_to_bf4(a), pb = f32_to_bf4(b); *(u32x4v*)(Z + (size_t)m * 8192 + col) = (u32x4v){pa.x, pa.y, pb.x, pb.y}; }
                    else { v[2 * q] = a; v[2 * q + 1] = b; } }
        }
#pragma unroll
        for (int q = 0; q < 16; ++q) s += (v[q].x + v[q].y) + (v[q].z + v[q].w);
        const float mu = wave_sum(s, F.lane) * (1.0f / DSGU); float s2 = 0.f;
#pragma unroll
        for (int q = 0; q < 16; ++q) { v[q] = v[q] - mu; s2 += (v[q].x * v[q].x + v[q].y * v[q].y) + (v[q].z * v[q].z + v[q].w * v[q].w); }
        const float rstd = 1.0f / sqrtf(wave_sum(s2, F.lane) * (1.0f / DSGU) + EPS);
        float* fo = nullptr;
        if (m >= TPROMPT) fo = outp() + O_VS + (size_t)(m - TPROMPT) * DSGU;
        else { const int t = m & (SEQ - 1); if (t >= SEQ - CHUNK) fo = outp() + O_VP + ((size_t)(m >> 11) * CHUNK + (t - (SEQ - CHUNK))) * DSGU; }
#pragma unroll
        for (int q = 0; q < 8; ++q) { const int e = (64 * q + F.lane) * 2;
            const f32x4 a = (v[2 * q] * rstd) * ((const f32x4*)lg)[e] + ((const f32x4*)lb)[e];
            const f32x4 b = (v[2 * q + 1] * rstd) * ((const f32x4*)lg)[e + 1] + ((const f32x4*)lb)[e + 1];
            const u32x2v pa = f32_to_bf4(a), pb = f32_to_bf4(b);
            ((u32x4v*)vr)[64 * q + F.lane] = (u32x4v){pa.x, pa.y, pb.x, pb.y};
            if (fo) { ((f32x4*)fo)[e] = a; ((f32x4*)fo)[e + 1] = b; } }
    }
}
__device__ __forceinline__ void phase_sguMix(Frame& F) {
    relaunder(F);
    const bf16* Z = (const bf16*)(wsp() + WS_ACT); bf16* Y = (bf16*)(wsp() + WS_Y); const bf16* WSB = (const bf16*)(wsp() + WS_WSB); const float* bs = inp(23);
    constexpr int VST = 544;
    const int l15 = F.lane & 15, g4 = F.lane >> 4;
    for (int it = F.vcu; it < 64 * NG * 2; it += F.G) {
        const int q = it >> 4, g = (it >> 1) & 7, h = it & 1; const size_t m0 = (size_t)q * CHUNK; const int colv = g * DG + h * 256;
        __syncthreads();
#pragma unroll
        for (int i = 0; i < 8; ++i) { const int idx = F.tid + 512 * i, s = idx >> 5, ch = idx & 31;
            const u32x4v raw = *(const u32x4v*)(Z + (m0 + s) * 8192 + DSGU + colv + ch * 8);
            *(LAS u32x4v*)(F.lds + s * VST + ch * 16) = raw; }
        __syncthreads();
#pragma unroll
        for (int job = 0; job < 2; ++job) {
            const int tb = job ? 7 - F.wave : F.wave, dbase = job * 8, nks = (tb + 2) >> 1;
            f32x4 acc[8];
#pragma unroll
            for (int dt = 0; dt < 8; ++dt) acc[dt] = (f32x4){0.f, 0.f, 0.f, 0.f};
            for (int ks = 0; ks < nks; ++ks) {
                const bf16* wrow = WSB + ((size_t)g * CHUNK + 16 * tb + l15) * CHUNK + 32 * ks + 4 * g4;
                const u32x2v wlo = *(const u32x2v*)wrow, whi = *(const u32x2v*)(wrow + 16);
                const bf16x8 wf = __builtin_bit_cast(bf16x8, (u32x4v){wlo.x, wlo.y, whi.x, whi.y});
                LAS unsigned char* vb = F.lds + (32 * ks + 4 * g4 + (l15 >> 2)) * VST + (16 * dbase + 4 * (l15 & 3)) * 2;
#pragma unroll
                for (int dt = 0; dt < 8; ++dt) {
                    const s16x4 lo = __builtin_bit_cast(s16x4, __builtin_amdgcn_ds_read_tr16_b64_v4i16((LAS s16x4*)(vb + dt * 32)));
                    const s16x4 hi = __builtin_bit_cast(s16x4, __builtin_amdgcn_ds_read_tr16_b64_v4i16((LAS s16x4*)(vb + dt * 32 + 16 * VST)));
                    const bf16x8 vf = (bf16x8){lo[0], lo[1], lo[2], lo[3], hi[0], hi[1], hi[2], hi[3]};
                    acc[dt] = __builtin_amdgcn_mfma_f32_16x16x32_bf16(vf, wf, acc[dt], 0, 0, 0);
                }
            }
            const int t = 16 * tb + l15; const float bias = bs[g * CHUNK + t];
#pragma unroll
            for (int dt = 0; dt < 8; ++dt) { const int col = colv + 16 * (dbase + dt) + 4 * g4;
                const f32x4 u = bf4_to_f32(*(const u32x2v*)(Z + (m0 + t) * 8192 + col));
                *(u32x2v*)(Y + (m0 + t) * DSGU + col) = f32_to_bf4(u * (acc[dt] + bias)); }
        }
    }
    const float* wsf = inp(22);
    for (int bq = F.gw; bq < NSB; bq += F.NGW) { const size_t m = TPROMPT + bq;
#pragma unroll
        for (int qq = 0; qq < 8; ++qq) { const int c = (64 * qq + F.lane) * 8, g = c >> 9; const float w00 = wsf[(size_t)g * CHUNK * CHUNK], b0 = bs[g * CHUNK];
            const u32x4v ur = *(const u32x4v*)(Z + m * 8192 + c), vr = *(const u32x4v*)(Z + m * 8192 + DSGU + c);
            const f32x4 ua = bf4_to_f32((u32x2v){ur.x, ur.y}), ub = bf4_to_f32((u32x2v){ur.z, ur.w}), va = bf4_to_f32((u32x2v){vr.x, vr.y}), vb2 = bf4_to_f32((u32x2v){vr.z, vr.w});
            const u32x2v pa = f32_to_bf4(ua * (va * w00 + b0)), pb = f32_to_bf4(ub * (vb2 * w00 + b0));
            *(u32x4v*)(Y + m * DSGU + c) = (u32x4v){pa.x, pa.y, pb.x, pb.y}; } }
}

template <class Epi> __device__ __forceinline__ void run_gemm(Frame& F, const bf16* A, const bf16* Bt, int N, int K, int nsplit, const Epi& E) {
    LAS unsigned char* lds = F.lds; relaunder(F);
    int bx = blockIdx.x, G = gridDim.x; asm volatile("" : "+s"(bx), "+s"(G));
    pg8::Gemm g{A, Bt, TP, N, K}; pg8::MixOrder S; S.init(TPROMPT, N, K, G, bx, TPROMPT / 256, nsplit);
    pg8::EpiSlab<Epi> ES{E, (float*)(wsp() + WS_SLAB), N};
    pg8::gemm_phase<pg8::EpiSlab<Epi>, pg8::MixOrder, true, true>(lds, g, S, ES, F.tid);
}
__global__ void __launch_bounds__(NWAVES * 64, 2) mk_fwd(Args args) {
    extern __shared__ __attribute__((aligned(16))) unsigned char lds_raw[];
    Frame F;
    F.lds = (LAS unsigned char*)lds_raw;
    { int w = __builtin_amdgcn_readfirstlane((int)threadIdx.x >> 6); asm volatile("" : "+s"(w)); F.wave0 = w; }
    relaunder(F);
    for (int u = F.tid; u < (LDS_BYTES - LDSCTL_OFF) / 4; u += NWAVES * 64) ((LAS unsigned*)(F.lds + LDSCTL_OFF))[u] = 0u;
    __syncthreads();
    (void)xcd_barrier_post((unsigned*)(wsp() + WS_CTL) + CW_BAR, (volatile LAS unsigned*)(F.lds + MISC_OFF) + 8, F.tid);
#define GRID_BAR() do { relaunder(F); XcdBarrier b_; b_.bar = (unsigned*)(wsp() + WS_CTL) + CW_BAR; b_.x = xb_xcc_id(); b_.st = (volatile LAS unsigned*)(F.lds + MISC_OFF) + 8; xcd_barrier(b_, F.tid); } while (0)
#define P_X   ((float*)(wsp() + WS_X))
#define P_XN  ((bf16*)(wsp() + WS_XN))
#define P_ACT ((bf16*)(wsp() + WS_ACT))
#define P_Y   ((bf16*)(wsp() + WS_Y))

    phase_prologue(F); phase_init(F); GRID_BAR();
#define P_RS  ((const float*)(wsp() + WS_RS))
#define P_PS  ((float*)(wsp() + WS_PS))
    for (int L = 0; L < DEPTH; ++L) {
        const int kind = L % 3, j = L / 3, nsp_out = (kind == 1) ? 16 : 8;
        for (int f = 0; f < 2; ++f) {
            { pg8::EpiPair<0> E{P_ACT, FF, nullptr, P_RS};
              run_gemm(F, P_XN, (const bf16*)(wsp() + WS_WGU + (size_t)(L * 2 + f) * SZ_WGU), 2 * FF, D, 1, E); }
            if (L * 2 + f + 1 < 2 * DEPTH) ffn_deferred(F, L * 2 + f + 1);
            GRID_BAR();
            { pg8::EpiResid E{P_X, P_XN, P_PS, D, 0.5f};
              run_gemm(F, P_ACT, (const bf16*)(wsp() + WS_WD + (size_t)(L * 2 + f) * SZ_WD), D, FF, NSPLIT_D, E); }
            GRID_BAR();
            if (f == 0) {
                phase_fix(F, NSPLIT_D, 0.5f); GRID_BAR();
                const bf16* wout; int kout;
                if (kind == 0) {
                    { pg8::EpiPair<1> E{P_ACT, D, inp(12) + (size_t)j * 4096, P_RS};
                      run_gemm(F, P_XN, (const bf16*)(wsp() + WS_WA1 + (size_t)j * SZ_WA1), 4096, D, 8, E); }
                    GRID_BAR();
                    phase_convA(F, j); GRID_BAR();
                    wout = (const bf16*)(wsp() + WS_WA2 + (size_t)j * SZ_WA2); kout = D;
                } else if (kind == 1) {
                    { pg8::EpiGelu E{P_ACT, 8192, inp(19), P_RS};
                      run_gemm(F, P_XN, (const bf16*)(wsp() + WS_WB1), 8192, D, 8, E); }
                    GRID_BAR();
                    phase_sguLN(F); GRID_BAR();
                    phase_sguMix(F); GRID_BAR();
                    wout = (const bf16*)(wsp() + WS_WB2); kout = DSGU;
                } else {
                    { pg8::EpiPair<2> E{P_ACT, 4096, nullptr, P_RS};
                      run_gemm(F, P_XN, (const bf16*)(wsp() + WS_WC1), 6144, D, 8, E); }
                    GRID_BAR();
                    phase_convC(F); GRID_BAR();
                    wout = (const bf16*)(wsp() + WS_WC2); kout = D;
                }
                { pg8::EpiResid E{P_X, P_XN, P_PS, D, 1.0f};
                  run_gemm(F, P_Y, wout, D, kout, nsp_out, E); }
                GRID_BAR();
                phase_fix(F, nsp_out, 1.0f); GRID_BAR();
            } else if (L < DEPTH - 1) { phase_fix(F, NSPLIT_D, 0.5f); GRID_BAR(); }
        }
    }
    phase_final(F);
}

extern "C" void kernel_launch(void* const* d_in, const int* in_sizes, int n_in, void* d_out, int out_size, void* d_ws, size_t ws_size, hipStream_t stream) {
    static int grid = 0;
    if (grid == 0) {
        if (n_in != 28 || (size_t)out_size != O_END || ws_size < WS_END) { fprintf(stderr, "kernel_launch: unexpected shapes (n_in %d, out %d, ws %zu)\n", n_in, out_size, ws_size); grid = -1; return; }
        int dev = 0, cus = 0, per_cu = 0;
        if (hipGetDevice(&dev) != hipSuccess || hipDeviceGetAttribute(&cus, hipDeviceAttributeMultiprocessorCount, dev) != hipSuccess) { grid = -1; return; }
        if (hipFuncSetAttribute((const void*)mk_fwd, hipFuncAttributeMaxDynamicSharedMemorySize, LDS_BYTES) != hipSuccess) { fprintf(stderr, "kernel_launch: hipFuncSetAttribute failed\n"); grid = -1; return; }
        if (hipOccupancyMaxActiveBlocksPerMultiprocessor(&per_cu, (const void*)mk_fwd, NWAVES * 64, LDS_BYTES) != hipSuccess || per_cu < 1) { fprintf(stderr, "kernel_launch: occupancy query says %d\n", per_cu); }
        (void)hipGetLastError();
        grid = cus;
    }
    if (grid < 0) return;
    (void)hipMemsetAsync((char*)d_ws + WS_CTL, 0, CTL_ZERO_BYTES, stream);
    Args a{};
    for (int i = 0; i < 28; ++i) a.in[i] = (const float*)d_in[i];
    a.out = (float*)d_out; a.ws = (unsigned char*)d_ws;
    hipLaunchKernelGGL(mk_fwd, dim3(grid), dim3(NWAVES * 64), LDS_BYTES, stream, a);
}
```
